# Optimizing an MI355X kernel written in HIP

```python
import jax, jax.numpy as jnp
from jax import lax
import numpy as np

D_MODEL = 2048
BATCH = 2
SEQ = 16384
DEPTH = 4

CHUNK = 64
N_A_LAYERS = DEPTH // 2
N_B_LAYERS = DEPTH - N_A_LAYERS
LRU_WIDTH = D_MODEL
LRU_BLOCKS = 8
LRU_BLOCK_DIM = LRU_WIDTH // LRU_BLOCKS
CONV_WIDTH = 4
LRU_C = 8.0
N_HEADS = 16
HEAD_DIM = D_MODEL // N_HEADS
D_FF = 4 * D_MODEL
Q_BLOCK = 128
KV_BLOCK = 128
NORM_EPS = 1e-6
NEG_INF = -1e30
N_MOD = 6

kernel_name = "yoco_rglru_fox_hybrid"


def rms_norm(x, g):
    xf = x.astype(jnp.float32)
    y = xf * lax.rsqrt(jnp.mean(jnp.square(xf), axis=-1, keepdims=True) + NORM_EPS)
    return (y * g.astype(jnp.float32)).astype(x.dtype)


def modulate(h, shift, scale):
    return h * (1 + scale) + shift


def block_diag_linear(x, w, b):
    xb = x.reshape(x.shape[:-1] + (LRU_BLOCKS, LRU_BLOCK_DIM))
    y = jnp.einsum('bsnc,ncd->bsnd', xb, w)
    return y.reshape(x.shape) + b


def causal_depthwise_conv(x, w, b):
    S = x.shape[1]
    xp = jnp.pad(x, ((0, 0), (CONV_WIDTH - 1, 0), (0, 0)))
    y = b
    for k in range(CONV_WIDTH):
        y = y + xp[:, k:k + S, :] * w[k]
    return y


def rg_lru(x, w_a, b_a, w_i, b_i, lam):
    f32 = jnp.float32
    xf = x.astype(f32)
    r = jax.nn.sigmoid(block_diag_linear(xf, w_a.astype(f32), b_a.astype(f32)))
    i = jax.nn.sigmoid(block_diag_linear(xf, w_i.astype(f32), b_i.astype(f32)))
    log_a = -LRU_C * r * jax.nn.softplus(-lam.astype(f32))
    a = jnp.exp(log_a)
    u = jnp.sqrt(-jnp.expm1(2.0 * log_a)) * (i * xf)

    def step(h, au):
        a_t, u_t = au
        h = a_t * h + u_t
        return h, h

    h0 = jnp.zeros((x.shape[0], x.shape[2]), f32)
    _, hs = lax.scan(step, h0, (jnp.swapaxes(a, 0, 1), jnp.swapaxes(u, 0, 1)))
    return jnp.swapaxes(hs, 0, 1).astype(x.dtype)


def shared_kv_stream(x, cs, kv_norm_g, kv_w_mod, kv_b_mod, w_kv, k_norm_g, w_forget, b_forget):
    B, S, _ = x.shape
    shift, scale = jnp.split((cs @ kv_w_mod + kv_b_mod)[:, None, :], 2, axis=-1)
    h = modulate(rms_norm(x, kv_norm_g), shift, scale)
    k, v = jnp.split(h @ w_kv, 2, axis=-1)
    k = rms_norm(k.reshape(B, S, N_HEADS, HEAD_DIM), k_norm_g)
    v = v.reshape(B, S, N_HEADS, HEAD_DIM)
    log_f = jax.nn.log_sigmoid((h @ w_forget + b_forget).astype(jnp.float32))
    F = jnp.cumsum(log_f, axis=1)
    return jnp.swapaxes(k, 1, 2), jnp.swapaxes(v, 1, 2), jnp.swapaxes(F, 1, 2)


def forgetting_attention(q, k, v, F):
    B, H, S, Dh = q.shape
    f32 = jnp.float32
    nq = S // Q_BLOCK
    qb = q.reshape(B, H, nq, Q_BLOCK, Dh).transpose(2, 0, 1, 3, 4)
    Fqb = F.reshape(B, H, nq, Q_BLOCK).transpose(2, 0, 1, 3)
    scale = Dh ** -0.5
    q_offs = jnp.arange(Q_BLOCK)
    k_offs = jnp.arange(KV_BLOCK)

    def one_block(args):
        qi, q_blk, fq = args
        q_blk = q_blk.astype(f32) * scale
        q_pos = qi * Q_BLOCK + q_offs

        def body(j, carry):
            m, l, acc = carry
            start = j * KV_BLOCK
            k_blk = lax.dynamic_slice_in_dim(k, start, KV_BLOCK, axis=2).astype(f32)
            v_blk = lax.dynamic_slice_in_dim(v, start, KV_BLOCK, axis=2).astype(f32)
            fk = lax.dynamic_slice_in_dim(F, start, KV_BLOCK, axis=2)
            s = jnp.einsum('bhqd,bhkd->bhqk', q_blk, k_blk) + fq[..., :, None] - fk[..., None, :]
            allowed = (start + k_offs)[None, :] <= q_pos[:, None]
            s = jnp.where(allowed, s, NEG_INF)
            m_new = jnp.maximum(m, jnp.max(s, axis=-1))
            p = jnp.exp(s - m_new[..., None])
            alpha = jnp.exp(m - m_new)
            l = l * alpha + jnp.sum(p, axis=-1)
            acc = acc * alpha[..., None] + jnp.einsum('bhqk,bhkd->bhqd', p, v_blk)
            return m_new, l, acc

        init = (jnp.full((B, H, Q_BLOCK), NEG_INF, f32),
                jnp.zeros((B, H, Q_BLOCK), f32),
                jnp.zeros((B, H, Q_BLOCK, Dh), f32))
        n_kv = ((qi + 1) * Q_BLOCK + KV_BLOCK - 1) // KV_BLOCK
        _, l, acc = lax.fori_loop(0, n_kv, body, init)
        return acc / l[..., None]

    out = lax.map(one_block, (jnp.arange(nq), qb, Fqb))
    out = out.transpose(1, 0, 3, 2, 4).reshape(B, S, H * Dh)
    return out.astype(q.dtype)


def setup_inputs(seed: int = 0) -> dict:
    key = jax.random.key(seed)
    ks = iter(jax.random.split(key, 40))
    f32 = jnp.float32
    D, W, F, H, Dh = D_MODEL, LRU_WIDTH, D_FF, N_HEADS, HEAD_DIM
    NA, NB = N_A_LAYERS, N_B_LAYERS

    def nrm(shape, s):
        return jax.random.normal(next(ks), shape, f32) * s

    def gain(shape):
        return 1.0 + 0.02 * jax.random.normal(next(ks), shape, f32)

    u = jax.random.uniform(next(ks), (NA, W), f32, minval=0.9, maxval=0.999)
    a0 = u ** (1.0 / LRU_C)
    lam = jnp.log(a0) - jnp.log1p(-a0)
    return {
        "x": nrm((BATCH, SEQ, D), 1.0),
        "c": nrm((BATCH, D), 1.0),
        "mix_norm_g": gain((DEPTH, D)),
        "mlp_norm_g": gain((DEPTH, D)),
        "w_mod": nrm((DEPTH, D, N_MOD * D), D ** -0.5),
        "b_mod": nrm((DEPTH, N_MOD * D), 0.01),
        "w_mlp_in": nrm((DEPTH, D, F), D ** -0.5),
        "w_mlp_out": nrm((DEPTH, F, D), F ** -0.5),
        "lru_w_in": nrm((NA, D, 2 * W), D ** -0.5),
        "lru_conv_w": nrm((NA, CONV_WIDTH, W), CONV_WIDTH ** -0.5),
        "lru_conv_b": nrm((NA, W), 0.01),
        "lru_w_a": nrm((NA, LRU_BLOCKS, LRU_BLOCK_DIM, LRU_BLOCK_DIM), LRU_BLOCK_DIM ** -0.5),
        "lru_b_a": nrm((NA, W), 0.01),
        "lru_w_i": nrm((NA, LRU_BLOCKS, LRU_BLOCK_DIM, LRU_BLOCK_DIM), LRU_BLOCK_DIM ** -0.5),
        "lru_b_i": nrm((NA, W), 0.01),
        "lru_lambda": lam,
        "lru_w_out": nrm((NA, W, D), W ** -0.5),
        "kv_norm_g": gain((D,)),
        "kv_w_mod": nrm((D, 2 * D), D ** -0.5),
        "kv_b_mod": nrm((2 * D,), 0.01),
        "w_kv": nrm((D, 2 * D), D ** -0.5),
        "k_norm_g": gain((Dh,)),
        "w_forget": nrm((D, H), D ** -0.5),
        "b_forget": jax.random.uniform(next(ks), (H,), f32, minval=1.0, maxval=5.0),
        "attn_w_q": nrm((NB, D, D), D ** -0.5),
        "q_norm_g": gain((NB, Dh)),
        "attn_w_o": nrm((NB, D, D), D ** -0.5),
    }


def reference(x, c, mix_norm_g, mlp_norm_g, w_mod, b_mod, w_mlp_in, w_mlp_out,
              lru_w_in, lru_conv_w, lru_conv_b, lru_w_a, lru_b_a, lru_w_i, lru_b_i,
              lru_lambda, lru_w_out, kv_norm_g, kv_w_mod, kv_b_mod, w_kv, k_norm_g,
              w_forget, b_forget, attn_w_q, q_norm_g, attn_w_o):
    B, S, _ = x.shape
    cs = jax.nn.silu(c)
    for layer in range(DEPTH):
        mod = (cs @ w_mod[layer] + b_mod[layer])[:, None, :]
        sh1, sc1, g1, sh2, sc2, g2 = jnp.split(mod, N_MOD, axis=-1)
        if layer == N_A_LAYERS:
            k, v, F = shared_kv_stream(x, cs, kv_norm_g, kv_w_mod, kv_b_mod, w_kv,
                                       k_norm_g, w_forget, b_forget)
        h = modulate(rms_norm(x, mix_norm_g[layer]), sh1, sc1)
        if layer < N_A_LAYERS:
            a = layer
            xb, yb = jnp.split(h @ lru_w_in[a], 2, axis=-1)
            xb = causal_depthwise_conv(xb, lru_conv_w[a], lru_conv_b[a])
            xb = rg_lru(xb, lru_w_a[a], lru_b_a[a], lru_w_i[a], lru_b_i[a], lru_lambda[a])
            mix = (xb * jax.nn.gelu(yb)) @ lru_w_out[a]
        else:
            bl = layer - N_A_LAYERS
            q = (h @ attn_w_q[bl]).reshape(B, S, N_HEADS, HEAD_DIM)
            q = jnp.swapaxes(rms_norm(q, q_norm_g[bl]), 1, 2)
            mix = forgetting_attention(q, k, v, F) @ attn_w_o[bl]
        x = x + g1 * mix
        h = modulate(rms_norm(x, mlp_norm_g[layer]), sh2, sc2)
        x = x + g2 * (jnp.square(jax.nn.relu(h @ w_mlp_in[layer])) @ w_mlp_out[layer])
    return x
```

```cpp
#include <hip/hip_runtime.h>
#include <hip/hip_bf16.h>
#include <cstdio>
#include <cstdint>

constexpr int BATCH = 2, SEQ = 16384, DM = 2048, FF = 8192, NH = 16, DH = 128, NLAYER = 4, NA = 2;
constexpr int M = BATCH * SEQ;
constexpr float NORM_EPS = 1e-6f;
constexpr int NCOLS_MOD = NLAYER * 6 * DM + 2 * DM;
constexpr int KSPLIT = 8;
constexpr int NWAVES = 8;
constexpr int CHUNK = 64;
constexpr int NCHUNK = M / CHUNK;

constexpr size_t MiB = 1u << 20;
constexpr size_t WS_CTL = 0, CTL_ZERO_BYTES = 1 * MiB;
constexpr size_t WS_MODP = 1 * MiB;
constexpr size_t WS_MOD = 5 * MiB;
constexpr size_t WS_C8 = 6 * MiB;
constexpr size_t WS_LOGF = 7 * MiB;
constexpr size_t WS_F = 9 * MiB;
constexpr size_t WS_PC = 11 * MiB, WS_HC = 15 * MiB, WS_CARRY = 19 * MiB;
constexpr size_t WS_WMLP_IN = 24 * MiB;
constexpr size_t WS_WMLP_OUT = 56 * MiB;
constexpr size_t WS_WMIX = 88 * MiB;
constexpr size_t WS_WMIX_B = WS_WMIX + 16 * MiB, WS_WMIX_C = WS_WMIX + 24 * MiB;
constexpr size_t WS_WKV = WS_WMIX + 16 * MiB;
constexpr size_t WS_H = 128 * MiB;
constexpr size_t WS_R1 = 256 * MiB;
constexpr size_t WS_R2A = 768 * MiB;
constexpr size_t WS_R2B = 896 * MiB;
constexpr size_t WS_R2C = 1024 * MiB;
constexpr size_t WS_K = 1152 * MiB, WS_V = 1280 * MiB;
constexpr size_t WS_END = 1408 * MiB;
constexpr int CW_BAR = 4096;

constexpr int RING_BYTES = 131072;
constexpr int LDSCTL_OFF = RING_BYTES, MISC_OFF = LDSCTL_OFF + 320;
constexpr int LDS_BYTES = 147456;

#define GAS __attribute__((address_space(1)))
#define LAS __attribute__((address_space(3)))
typedef unsigned short bf16;
typedef unsigned v4u __attribute__((ext_vector_type(4)));
typedef float f32x4 __attribute__((ext_vector_type(4)));
typedef short bf16x8 __attribute__((ext_vector_type(8)));
typedef GAS unsigned gu32;
typedef GAS unsigned long long gu64;
#define GP(T, p) ((GAS T*)(p))
#define RLX_AGENT __ATOMIC_RELAXED, __HIP_MEMORY_SCOPE_AGENT
#define LDS_WAIT() asm volatile("s_waitcnt lgkmcnt(0)" ::: "memory")
#define VM_WAIT() asm volatile("s_waitcnt vmcnt(0)" ::: "memory")
__device__ __forceinline__ unsigned long long rt() { return __builtin_amdgcn_s_memrealtime(); }
__device__ __forceinline__ unsigned f2bf(float f) { unsigned u = __builtin_bit_cast(unsigned, f); return (u + 0x7fffu + ((u >> 16) & 1u)) >> 16; }
__device__ __forceinline__ unsigned pk2(float lo, float hi) { return f2bf(lo) | (f2bf(hi) << 16); }

#define XB_TMO      128
#define XB_XCNT(j)  (256  + 64 * (j))
#define XB_XSUB(j)  (1280 + 64 * (j))
#define XB_XGEN(j)  (2304 + 64 * (j))
#define XB_TOP      3328
#define XB_TOPGEN   3392
#define XCD_BAR_WORDS 3456
#define XB_SPIN_CAP (1u << 18)

__device__ __forceinline__ unsigned xb_ld(unsigned* p)              { return __hip_atomic_load(p, __ATOMIC_RELAXED, __HIP_MEMORY_SCOPE_AGENT); }
__device__ __forceinline__ unsigned xb_add(unsigned* p, unsigned v) { return __hip_atomic_fetch_add(p, v, __ATOMIC_RELAXED, __HIP_MEMORY_SCOPE_AGENT); }
__device__ __forceinline__ unsigned xb_xcc_id() { return (unsigned)__builtin_amdgcn_s_getreg((3 << 11) | 20) & 0xFu; }
#define XB_SPIN(cond, bar) do { unsigned _sp = 0; while (cond) { __builtin_amdgcn_s_sleep(1); \
    if ((++_sp & 255u) == 0u) { if (xb_ld(&(bar)[XB_TMO])) break; if (_sp > XB_SPIN_CAP) { atomicAdd(&(bar)[XB_TMO], 1u); break; } } } } while (0)

struct XcdBarrier {
    unsigned* bar; unsigned x;
    volatile LAS unsigned* st;
};

__device__ __forceinline__ XcdBarrier xcd_barrier_post(unsigned* bar, volatile LAS unsigned* st) {
    XcdBarrier b; b.bar = bar; b.x = xb_xcc_id(); b.st = st;
    if (threadIdx.x == 0) (void)xb_add(&bar[XB_XCNT(b.x)], 1u);
    return b;
}
__device__ __forceinline__ void xcd_barrier_complete(unsigned* bar, unsigned x, unsigned& nloc, unsigned& nx) {
    const unsigned G = gridDim.x * gridDim.y * gridDim.z;
    unsigned sum, cnt, mine, sp = 0u;
    for (;;) {
        sum = 0u; cnt = 0u; mine = 0u;
#pragma unroll
        for (unsigned j = 0; j < 16; ++j) { const unsigned c = xb_ld(&bar[XB_XCNT(j)]); sum += c; cnt += (c > 0u) ? 1u : 0u; mine = (j == x) ? c : mine; }
        if (sum == G) break;
        __builtin_amdgcn_s_sleep(1);
        if ((++sp & 255u) == 0u) { if (xb_ld(&bar[XB_TMO])) break; if (sp > XB_SPIN_CAP) { atomicAdd(&bar[XB_TMO], 1u); break; } }
    }
    nloc = mine > 0u ? mine : 1u; nx = cnt > 0u ? cnt : 1u;
}

__device__ __forceinline__ void xcd_barrier(const XcdBarrier& b) {
    asm volatile("s_waitcnt vmcnt(0)" ::: "memory");
    __syncthreads();
    if (threadIdx.x == 0) {
        unsigned* bar = b.bar;
        __builtin_amdgcn_s_waitcnt(0);
        unsigned nloc = b.st[0], nx = b.st[1];
        if (nloc == 0u) { xcd_barrier_complete(bar, b.x, nloc, nx); b.st[0] = nloc; b.st[1] = nx; }
        const unsigned old = xb_add(&bar[XB_XSUB(b.x)], 1u);
        const unsigned gen = old / nloc;
        if (old + 1u == (gen + 1u) * nloc) {
            __builtin_amdgcn_fence(__ATOMIC_RELEASE, "agent");
            asm volatile("s_waitcnt vmcnt(0)" ::: "memory");
            const unsigned og = xb_add(&bar[XB_TOP], 1u);
            const unsigned tg = og / nx;
            if (og + 1u == (tg + 1u) * nx) xb_add(&bar[XB_TOPGEN], 1u);
            else XB_SPIN(xb_ld(&bar[XB_TOPGEN]) == tg, bar);
            __builtin_amdgcn_fence(__ATOMIC_ACQUIRE, "agent");
            xb_add(&bar[XB_XGEN(b.x)], 1u);
            asm volatile("s_waitcnt vmcnt(0)" ::: "memory");
        } else {
            XB_SPIN(xb_ld(&bar[XB_XGEN(b.x)]) == gen, bar);
            __builtin_amdgcn_fence(__ATOMIC_ACQUIRE, "agent");
            asm volatile("s_waitcnt vmcnt(0)" ::: "memory");
        }
    }
    __syncthreads();
}

namespace pg8 {
#define PG8_LAS __attribute__((address_space(3)))
#define PG8_GAS __attribute__((address_space(1)))
typedef unsigned short bf16_t;
typedef short bf16x8 __attribute__((ext_vector_type(8)));
typedef float f32x4 __attribute__((ext_vector_type(4)));
typedef float f32x2 __attribute__((ext_vector_type(2)));
typedef unsigned u32x4 __attribute__((ext_vector_type(4)));
typedef unsigned u32x2 __attribute__((ext_vector_type(2)));
constexpr int BM = 256, BK = 64, HALF = 128, HTB = HALF * BK * 2, STAGE_BYTES = 8 * HTB, NXCD = 8, WGM = 8;

__host__ __device__ __forceinline__ int lds_byte(int r, int c) { const int st = (r >> 4) * 2 + (c >> 5), rr = r & 15, cc = c & 31, ob = rr * 64 + cc * 2; return st * 1024 + (ob ^ (((ob >> 9) & 1) << 5)); }
__host__ __device__ __forceinline__ void stage_rc(int b, int& R, int& C) { const int st = b / 1024, sb = b % 1024, swz = sb ^ (((sb >> 9) & 1) << 5); R = (st >> 1) * 16 + swz / 64; C = (st & 1) * 32 + (swz % 64) / 2; }
__host__ __device__ __forceinline__ int perm32(int rho) { const int n = rho >> 4, i = rho & 15; return 8 * (i >> 2) + 4 * n + (i & 3); }

struct Unit { int pm, pn; };
struct Gemm { const bf16_t* A; const bf16_t* Bt; int lda, ldb, K, adiv; };

struct StaticOrder {
    int nM, nN, nwg, G, c;
    __host__ __device__ void init(int M_, int N_, int G_, int c_) { nM = M_ / BM; nN = N_ / BM; nwg = nM * nN; G = G_; c = c_; }
    __host__ __device__ bool next(int i, Unit& u) const {
        const long L = (long)i * G + c; if (L >= nwg) return false;
        int wgid = (int)L; { const int q = nwg / NXCD, r = nwg % NXCD, xcd = wgid % NXCD, off = wgid / NXCD; wgid = (xcd < r ? xcd * (q + 1) : r * (q + 1) + (xcd - r) * q) + off; }
        const int nig = WGM * nN, gid = wgid / nig, fm = gid * WGM, gsz = (nM - fm) < WGM ? (nM - fm) : WGM;
        u.pm = fm + ((wgid % nig) % gsz); u.pn = (wgid % nig) / gsz; return true;
    }
};

__device__ __forceinline__ unsigned cvt_pk_bf16(float lo, float hi) { unsigned r; asm volatile("v_cvt_pk_bf16_f32 %0, %1, %2" : "=v"(r) : "v"(lo), "v"(hi)); return r; }
__device__ __forceinline__ float bf_lo(unsigned w) { return __uint_as_float(w << 16); }
__device__ __forceinline__ float bf_hi(unsigned w) { return __uint_as_float(w & 0xffff0000u); }
__device__ __forceinline__ float fast_sigmoid(float z) { return __builtin_amdgcn_rcpf(1.0f + __builtin_amdgcn_exp2f(-1.4426950408889634f * z)); }
__device__ __forceinline__ float gelu_tanh(float y) { const float z = 0.7978845608028654f * (y + 0.044715f * y * y * y); return y * fast_sigmoid(2.0f * z); }

template <int ACT> struct EpiBf16 {
    static constexpr bool PERM = true;
    bf16_t* O; int ldc; int split_tiles; size_t split_stride; int act_from;
    __device__ __forceinline__ void operator()(const f32x4 (&acc)[2][2][4][2], const Unit& u, int wr, int wc, int fr, int fq) const {
        int pn = u.pn; bf16_t* base = O;
        if (split_tiles) { const int t = pn / split_tiles; base += (size_t)t * split_stride; pn -= t * split_tiles; }
        const int col0 = pn * BM + wc * 32 + 8 * fq;
        const bool act1 = (ACT == 1) && (u.pn >= act_from);
        const unsigned e0 = ((unsigned)(wr * 64 + fr) * (unsigned)ldc + (unsigned)col0) * 2u;
        char* pb = (char*)(base + (size_t)u.pm * BM * ldc);
#pragma unroll
        for (int ai = 0; ai < 2; ++ai)
#pragma unroll
            for (int m = 0; m < 4; ++m) { bf16_t* rowp = (bf16_t*)(pb + (e0 + (unsigned)((ai * HALF + m * 16) * 2) * (unsigned)ldc));
#pragma unroll
                for (int bj = 0; bj < 2; ++bj) { f32x4 v0 = acc[ai][bj][m][0], v1 = acc[ai][bj][m][1];
                    if (ACT == 1) { if (act1) {
#pragma unroll
                        for (int j = 0; j < 4; ++j) { v0[j] = gelu_tanh(v0[j]); v1[j] = gelu_tanh(v1[j]); } } }
                    if (ACT == 2) {
#pragma unroll
                        for (int j = 0; j < 4; ++j) { const float a = fmaxf(v0[j], 0.f), b = fmaxf(v1[j], 0.f); v0[j] = a * a; v1[j] = b * b; } }
                    u32x4 w; w.x = cvt_pk_bf16(v0[0], v0[1]); w.y = cvt_pk_bf16(v0[2], v0[3]); w.z = cvt_pk_bf16(v1[0], v1[1]); w.w = cvt_pk_bf16(v1[2], v1[3]);
                    *(PG8_GAS u32x4*)((PG8_GAS bf16_t*)rowp + bj * HALF) = w; } }
    }
};
struct EpiResid {
    static constexpr bool PERM = false;
    const float* base; float* out; const float* gate;
    __device__ __forceinline__ void operator()(const f32x4 (&acc)[2][2][4][2], const Unit& u, int wr, int wc, int fr, int fq) const {
        const int col0 = u.pn * BM + wc * 32 + 4 * fq; const int b = (u.pm * BM) / SEQ;
        f32x4 gv[2][2];
#pragma unroll
        for (int bj = 0; bj < 2; ++bj)
#pragma unroll
            for (int n = 0; n < 2; ++n) gv[bj][n] = *(const PG8_GAS f32x4*)((const PG8_GAS float*)gate + (size_t)b * NCOLS_MOD + col0 + bj * HALF + n * 16);
        const unsigned e0 = ((unsigned)(wr * 64 + fr) * DM + (unsigned)col0) * 4u;
        const char* bb = (const char*)(base + (size_t)u.pm * BM * DM); char* ob = (char*)(out + (size_t)u.pm * BM * DM);
#pragma unroll
        for (int ai = 0; ai < 2; ++ai)
#pragma unroll
            for (int m = 0; m < 4; ++m) {
#pragma unroll
                for (int bj = 0; bj < 2; ++bj)
#pragma unroll
                    for (int n = 0; n < 2; ++n) { const unsigned e = e0 + (unsigned)(((ai * HALF + m * 16) * DM + bj * HALF + n * 16) * 4);
                        const f32x4 bs = *(const PG8_GAS f32x4*)((const PG8_GAS char*)bb + e);
                        *(PG8_GAS f32x4*)((PG8_GAS char*)ob + e) = bs + gv[bj][n] * acc[ai][bj][m][n]; }
                if (m & 1) asm volatile("" ::: "memory"); }
    }
};
struct EpiGate {
    static constexpr bool PERM = false;
    const bf16_t* xc; const float* b_a; const float* b_i; const float* c8; float* Aa; float* Uu;
    __device__ __forceinline__ void operator()(const f32x4 (&acc)[2][2][4][2], const Unit& u, int wr, int wc, int fr, int fq) const {
        const int ch0 = (u.pn >> 1) * 256 + (u.pn & 1) * 128 + wc * 32 + 4 * fq;
        const unsigned e0 = (unsigned)(wr * 64 + fr) * DM + (unsigned)ch0;
        const char* xcb = (const char*)(xc + (size_t)u.pm * BM * DM); char* ab = (char*)(Aa + (size_t)u.pm * BM * DM); char* ub = (char*)(Uu + (size_t)u.pm * BM * DM);
#pragma unroll
        for (int n = 0; n < 2; ++n) { const f32x4 ba = *(const PG8_GAS f32x4*)((const PG8_GAS float*)b_a + ch0 + n * 16), bi = *(const PG8_GAS f32x4*)((const PG8_GAS float*)b_i + ch0 + n * 16), cc = *(const PG8_GAS f32x4*)((const PG8_GAS float*)c8 + ch0 + n * 16);
#pragma unroll
            for (int ai = 0; ai < 2; ++ai)
#pragma unroll
                for (int m = 0; m < 4; ++m) { const unsigned e = e0 + (unsigned)((ai * HALF + m * 16) * DM + n * 16);
                    const u32x2 xw = *(const PG8_GAS u32x2*)((const PG8_GAS char*)xcb + e * 2u);
                    const float xv[4] = {bf_lo(xw.x), bf_hi(xw.x), bf_lo(xw.y), bf_hi(xw.y)};
                    f32x4 av, uv;
#pragma unroll
                    for (int j = 0; j < 4; ++j) { const float r = fast_sigmoid(acc[ai][0][m][n][j] + ba[j]), ig = fast_sigmoid(acc[ai][1][m][n][j] + bi[j]);
                        const float la = cc[j] * r; const float a = __builtin_amdgcn_exp2f(1.4426950408889634f * la); const float a2 = __builtin_amdgcn_exp2f(2.8853900817779268f * la);
                        av[j] = a; uv[j] = __builtin_amdgcn_sqrtf(fmaxf(1.0f - a2, 0.f)) * (ig * xv[j]); }
                    *(PG8_GAS f32x4*)((PG8_GAS char*)ab + e * 4u) = av; *(PG8_GAS f32x4*)((PG8_GAS char*)ub + e * 4u) = uv;
                    if (m & 1) asm volatile("" ::: "memory"); } }
    }
};

template <class Epi, class Sched>
__device__ __forceinline__ void gemm_phase(PG8_LAS unsigned char* lds, const Gemm g, const Sched& S, const Epi& E, const int tid  ) {
    const int wid = __builtin_amdgcn_readfirstlane(tid >> 6), lane = tid & 63, wr = wid >> 2, wc = wid & 3, fr = lane & 15, fq = lane >> 4;
    const int K = g.K, nt = K / BK, lda = g.lda, ldb = g.ldb;
    unsigned voffA[2], voffB[2];
#pragma unroll
    for (int i = 0; i < 2; ++i) { int R, C; stage_rc(tid * 16 + i * 8192, R, C); const int Rb = Epi::PERM ? ((R & ~31) + perm32(R & 31)) : R;
        voffA[i] = (unsigned)(R * lda + C) * 2u; voffB[i] = (unsigned)(Rb * ldb + C) * 2u; }
    const size_t kstep = (size_t)(BK * 2);
    const size_t hstepA = (size_t)HALF * lda * 2, hstepB = (size_t)HALF * ldb * 2;
    const size_t tstepA = 2 * hstepA, tstepB = 2 * hstepB;
    const unsigned ldsw = (unsigned)wid * 1024u;
    const int aoff = lds_byte(wr * 64 + fr, fq * 8), boff = lds_byte(wc * 32 + fr, fq * 8);
#define PG8_SA(b, h) (((b) * 2 + (h)) * HTB)
#define PG8_SB(b, h) ((4 + (b) * 2 + (h)) * HTB)
#define PG8_STAGE(bufoff, gbase, voff) do { _Pragma("unroll") for (int _i = 0; _i < 2; ++_i) \
        __builtin_amdgcn_global_load_lds((const PG8_GAS unsigned*)((const PG8_GAS char*)(gbase) + (voff)[_i]), (PG8_LAS unsigned*)(lds + (bufoff) + ldsw + _i * 8192), 16, 0, 0); } while (0)
#define PG8_LDA(dst, b, h) do { _Pragma("unroll") for (int m = 0; m < 4; ++m) _Pragma("unroll") for (int k = 0; k < 2; ++k) dst[m][k] = *(const PG8_LAS bf16x8*)(lds + PG8_SA(b, h) + aoff + m * 2048 + k * 1024); } while (0)
#define PG8_LDB(dst, b, h) do { _Pragma("unroll") for (int n = 0; n < 2; ++n) _Pragma("unroll") for (int k = 0; k < 2; ++k) dst[n][k] = *(const PG8_LAS bf16x8*)(lds + PG8_SB(b, h) + boff + n * 2048 + k * 1024); } while (0)
#define PG8_MMA(ai, bj, At, Bt) do { __builtin_amdgcn_s_setprio(1); _Pragma("unroll") for (int m = 0; m < 4; ++m) _Pragma("unroll") for (int n = 0; n < 2; ++n) _Pragma("unroll") for (int k = 0; k < 2; ++k) \
        acc[ai][bj][m][n] = __builtin_amdgcn_mfma_f32_16x16x32_bf16(Bt[n][k], At[m][k], acc[ai][bj][m][n], 0, 0, 0); __builtin_amdgcn_s_setprio(0); } while (0)
#define PG8_WAIT_V(n) asm volatile("s_waitcnt vmcnt(" #n ")" ::: "memory")
#define PG8_WAIT_L(n) asm volatile("s_waitcnt lgkmcnt(" #n ")" ::: "memory")
#define PG8_BAR __builtin_amdgcn_s_barrier()
#define PG8_SCHED __builtin_amdgcn_sched_barrier(0)
#define PG8_ABASE(u_) ((const char*)g.A + (size_t)(u_).pm * tstepA + (g.adiv ? (size_t)((u_).pn / g.adiv) * (size_t)K * 2 : (size_t)0))
#define PG8_BBASE(u_) ((const char*)g.Bt + (size_t)(u_).pn * tstepB)
    Unit cur, nxt; int ui = 0;
    if (!S.next(0, cur)) return;
    f32x4 acc[2][2][4][2];
#pragma unroll
    for (int a = 0; a < 2; ++a)
#pragma unroll
        for (int b = 0; b < 2; ++b)
#pragma unroll
            for (int m = 0; m < 4; ++m)
#pragma unroll
                for (int n = 0; n < 2; ++n) acc[a][b][m][n] = (f32x4){0.f, 0.f, 0.f, 0.f};
    bf16x8 At[4][2], B0[2][2], B1[2][2];
    const char* cA = PG8_ABASE(cur); const char* cB = PG8_BBASE(cur);
    PG8_STAGE(PG8_SB(0, 0), cB, voffB); PG8_STAGE(PG8_SB(0, 1), cB + hstepB, voffB); PG8_STAGE(PG8_SA(0, 0), cA, voffA); PG8_STAGE(PG8_SA(0, 1), cA + hstepA, voffA);
    if (wr == 1) PG8_BAR;
    PG8_WAIT_V(2); PG8_BAR;
    PG8_STAGE(PG8_SB(1, 0), cB + kstep, voffB); PG8_STAGE(PG8_SA(1, 0), cA + kstep, voffA); PG8_STAGE(PG8_SB(1, 1), cB + hstepB + kstep, voffB);
    PG8_WAIT_V(6); PG8_BAR;
    for (;;) {
        const bool has_next = S.next(ui + 1, nxt);
        const char* nA = has_next ? PG8_ABASE(nxt) : cA; const char* nB = has_next ? PG8_BBASE(nxt) : cB;
#pragma clang loop unroll(disable)
        for (int t = 0; t < nt; t += 2) {
            const bool last = (t == nt - 2);
            const char* a1 = cA + (size_t)(t + 1) * kstep;
            const char* a2 = last ? nA : cA + (size_t)(t + 2) * kstep; const char* b2 = last ? nB : cB + (size_t)(t + 2) * kstep;
            const char* a3 = a2 + kstep; const char* b3 = b2 + kstep;
            PG8_LDB(B0, 0, 0); PG8_LDB(B1, 0, 1); PG8_SCHED; PG8_LDA(At, 0, 0); PG8_STAGE(PG8_SA(1, 1), a1 + hstepA, voffA);
            PG8_WAIT_V(8); PG8_WAIT_L(0); PG8_BAR; PG8_MMA(0, 0, At, B0); PG8_MMA(0, 1, At, B1); PG8_BAR; PG8_SCHED;
            PG8_LDA(At, 0, 1); PG8_STAGE(PG8_SB(0, 0), b2, voffB); PG8_STAGE(PG8_SB(0, 1), b2 + hstepB, voffB); PG8_STAGE(PG8_SA(0, 0), a2, voffA);
            PG8_WAIT_V(8); PG8_WAIT_L(0); PG8_BAR; PG8_MMA(1, 0, At, B0); PG8_MMA(1, 1, At, B1); PG8_BAR; PG8_SCHED;
            PG8_LDB(B0, 1, 0); PG8_LDB(B1, 1, 1); PG8_SCHED; PG8_LDA(At, 1, 0); PG8_STAGE(PG8_SA(0, 1), a2 + hstepA, voffA);
            PG8_WAIT_V(8); PG8_WAIT_L(0); PG8_BAR; PG8_MMA(0, 0, At, B0); PG8_MMA(0, 1, At, B1); PG8_BAR; PG8_SCHED;
            PG8_LDA(At, 1, 1); PG8_STAGE(PG8_SB(1, 0), b3, voffB); PG8_STAGE(PG8_SB(1, 1), b3 + hstepB, voffB); PG8_STAGE(PG8_SA(1, 0), a3, voffA);
            PG8_WAIT_V(8); PG8_WAIT_L(0); PG8_BAR; PG8_MMA(1, 0, At, B0); PG8_MMA(1, 1, At, B1); PG8_BAR; PG8_SCHED;
        }
        if (wr == 0) PG8_BAR;
        E(acc, cur, wr, wc, fr, fq);
        if (!has_next) break;
#pragma unroll
        for (int a = 0; a < 2; ++a)
#pragma unroll
            for (int b = 0; b < 2; ++b)
#pragma unroll
                for (int m = 0; m < 4; ++m)
#pragma unroll
                    for (int n = 0; n < 2; ++n) acc[a][b][m][n] = (f32x4){0.f, 0.f, 0.f, 0.f};
        cur = nxt; cA = nA; cB = nB; ++ui;
        if (wr == 1) PG8_BAR;
    }
    PG8_WAIT_V(0);
    PG8_BAR;
#undef PG8_SA
#undef PG8_SB
#undef PG8_STAGE
#undef PG8_LDA
#undef PG8_LDB
#undef PG8_MMA
#undef PG8_WAIT_V
#undef PG8_WAIT_L
#undef PG8_BAR
#undef PG8_SCHED
#undef PG8_ABASE
#undef PG8_BBASE
}
}

namespace fox {
#define FOX_GAS __attribute__((address_space(1)))
using bf16 = __hip_bfloat16;
typedef short bf16x8 __attribute__((ext_vector_type(8)));
typedef short s16x4 __attribute__((ext_vector_type(4)));
typedef float f32x16 __attribute__((ext_vector_type(16)));
typedef float f32x4 __attribute__((ext_vector_type(4)));
typedef unsigned u32x4 __attribute__((ext_vector_type(4)));
constexpr int D = 128, RS = 2048;
constexpr float SCALE = 0.08838834764831845f, INV_SCALE = 11.313708498984761f;
constexpr float THR = 8.f;
constexpr int NW = 8, QBLK = 32, KVBLK = 64, QB = NW * QBLK;
constexpr int SHM_V = KVBLK * D * 2, SHM_K = KVBLK * D * 2;
constexpr int OFF_WS = 2 * SHM_V + 2 * SHM_K, OFF_F = OFF_WS + NW * 64 * 4;
constexpr int LDS_BYTES_ATT = OFF_F + 2 * 64 * 4;
constexpr unsigned WBIG = 0x40000000u;

#define KSWZ(row, colB) ((row) * 256 + ((colB) ^ (((row) & 7) << 4)))
#define SBAR() __builtin_amdgcn_sched_barrier(0)
__device__ __forceinline__ int v_st(int k, int c) { const int kk = (k & ~0xC) | ((k & 4) << 1) | ((k & 8) >> 1); return ((kk >> 3) * 4 + (c >> 5)) * 512 + ((kk & 7) * 32 + (c & 31)) * 2; }
__device__ __forceinline__ int v_rd_base(int lane) { return ((lane & 3) << 3) | (((lane >> 2) & 3) << 6) | (((lane >> 4) & 1) << 5) | (((lane >> 5) & 1) << 8); }
constexpr int v_rd_off(int d0, int ks, int half) { return d0 * 512 + ks * 4096 + half * 2048; }
__device__ __forceinline__ int crow(int r, int hi) { return (r & 3) + 8 * (r >> 2) + 4 * hi; }
__device__ __forceinline__ unsigned cvtpk(float lo, float hi) { unsigned r; asm volatile("v_cvt_pk_bf16_f32 %0, %1, %2" : "=v"(r) : "v"(lo), "v"(hi)); return r; }
__device__ __forceinline__ bf16x8 load8(const bf16* p) { return *reinterpret_cast<const bf16x8*>(p); }
__device__ __forceinline__ void mask_tile(f32x16& p0, f32x16& p1, int dq) {
    const float NEG = -__builtin_inff();
#pragma unroll
    for (int r = 0; r < 16; ++r) {
        const int c = (r & 3) + 8 * (r >> 2);
        if ((unsigned)(dq - c) >= WBIG) p0[r] = NEG;
        if ((unsigned)(dq - c - 32) >= WBIG) p1[r] = NEG;
    }
}
__device__ __forceinline__ void partialSM(f32x16& p0, f32x16& p1, float& m_reg, float& mn, float& alpha) {
    float pmax = p0[0]; for (int r = 1; r < 16; ++r) pmax = fmaxf(pmax, p0[r]); for (int r = 0; r < 16; ++r) pmax = fmaxf(pmax, p1[r]);
    { auto rr = __builtin_amdgcn_permlane32_swap(__float_as_uint(pmax), __float_as_uint(pmax), false, false);
      pmax = fmaxf(__uint_as_float(rr[0]), __uint_as_float(rr[1])); }
    constexpr float C2 = 1.4426950408889634f * SCALE;
    if (__builtin_expect(__all((pmax - m_reg) * SCALE <= THR), 1)) { mn = m_reg; alpha = 1.f; }
    else { mn = fmaxf(m_reg, pmax); alpha = __builtin_amdgcn_exp2f((m_reg - mn) * C2); m_reg = mn; }
    const float mnL = -mn * C2;
    for (int r = 0; r < 16; ++r) p0[r] = fmaf(p0[r], C2, mnL); for (int r = 0; r < 16; ++r) p1[r] = fmaf(p1[r], C2, mnL);
    for (int r = 0; r < 16; ++r) p0[r] = __builtin_amdgcn_exp2f(p0[r]);
}
__device__ __forceinline__ void finishSM(f32x16& p0, f32x16& p1, float alpha, float& l_reg, bf16x8& pa0, bf16x8& pa1, bf16x8& pa2, bf16x8& pa3) {
    for (int r = 0; r < 16; ++r) p1[r] = __builtin_amdgcn_exp2f(p1[r]);
    float ps = 0; for (int r = 0; r < 16; ++r) ps += p0[r]; for (int r = 0; r < 16; ++r) ps += p1[r];
    { auto rr = __builtin_amdgcn_permlane32_swap(__float_as_uint(ps), __float_as_uint(ps), false, false);
      ps = __uint_as_float(rr[0]) + __uint_as_float(rr[1]); }
    l_reg = l_reg * alpha + ps;
#define PK4(P, B_, OUT) do { unsigned a0 = cvtpk(P[B_+0], P[B_+1]), a1 = cvtpk(P[B_+2], P[B_+3]);                          \
        unsigned b0 = cvtpk(P[B_+4], P[B_+5]), b1 = cvtpk(P[B_+6], P[B_+7]);                                             \
        auto r0 = __builtin_amdgcn_permlane32_swap(a0, b0, false, false); auto r1 = __builtin_amdgcn_permlane32_swap(a1, b1, false, false); \
        u32x4 w = {r0[0], r1[0], r0[1], r1[1]}; OUT = *reinterpret_cast<bf16x8*>(&w); } while (0)
    PK4(p0, 0, pa0); PK4(p0, 8, pa1); PK4(p1, 0, pa2); PK4(p1, 8, pa3);
#undef PK4
}
template <int KB>
__device__ __forceinline__ void qkt(f32x16& p0, f32x16& p1, const char* K_lds, int r32, int hi, const bf16x8* qr) {
    { const float* fb = (const float*)(K_lds + 2 * SHM_K + NW * 256 + KB * 256) + 4 * hi;
      const f32x4 a0 = *(const f32x4*)(fb), a1 = *(const f32x4*)(fb + 8), a2 = *(const f32x4*)(fb + 16), a3 = *(const f32x4*)(fb + 24);
      const f32x4 b0 = *(const f32x4*)(fb + 32), b1 = *(const f32x4*)(fb + 40), b2 = *(const f32x4*)(fb + 48), b3 = *(const f32x4*)(fb + 56);
      p0 = (f32x16){a0[0], a0[1], a0[2], a0[3], a1[0], a1[1], a1[2], a1[3], a2[0], a2[1], a2[2], a2[3], a3[0], a3[1], a3[2], a3[3]};
      p1 = (f32x16){b0[0], b0[1], b0[2], b0[3], b1[0], b1[1], b1[2], b1[3], b2[0], b2[1], b2[2], b2[3], b3[0], b3[1], b3[2], b3[3]}; }
    const char* kb[4];
#pragma unroll
    for (int dd = 0; dd < 4; ++dd) kb[dd] = K_lds + KB * SHM_K + KSWZ(r32, (dd * 16 + hi * 8) * 2);
#pragma unroll
    for (int d0 = 0; d0 < 8; ++d0) { const char* a = kb[d0 & 3] + (d0 >> 2) * 128;
        bf16x8 b0 = *reinterpret_cast<const bf16x8*>(a);
        bf16x8 b1 = *reinterpret_cast<const bf16x8*>(a + 32 * 256);
        p0 = __builtin_amdgcn_mfma_f32_32x32x16_bf16(b0, qr[d0], p0, 0, 0, 0);
        p1 = __builtin_amdgcn_mfma_f32_32x32x16_bf16(b1, qr[d0], p1, 0, 0, 0); }
}
template <int VB>
__device__ __forceinline__ void pv_tile(f32x16* o, int vb0, bf16x8 pa0, bf16x8 pa1, bf16x8 pa2, bf16x8 pa3) {
#define TRRD(dst, off) asm volatile("ds_read_b64_tr_b16 %0, %1 offset:%2" : "=&v"(dst) : "v"(vb0), "i"(off) : "memory")
#define PV_D0(d0) do { s16x4 l0, l1, l2, l3, h0, h1, h2, h3; constexpr int b_ = VB * SHM_V + v_rd_off(d0, 0, 0);  \
        TRRD(l0, b_); TRRD(h0, b_ + 2048); TRRD(l1, b_ + 4096); TRRD(h1, b_ + 6144); TRRD(l2, b_ + 8192); TRRD(h2, b_ + 10240); TRRD(l3, b_ + 12288); TRRD(h3, b_ + 14336); \
        asm volatile("s_waitcnt lgkmcnt(0)" ::: "memory"); SBAR();   \
        o[d0] = __builtin_amdgcn_mfma_f32_32x32x16_bf16(pa0, (bf16x8){l0[0], l0[1], l0[2], l0[3], h0[0], h0[1], h0[2], h0[3]}, o[d0], 0, 0, 0);   \
        o[d0] = __builtin_amdgcn_mfma_f32_32x32x16_bf16(pa1, (bf16x8){l1[0], l1[1], l1[2], l1[3], h1[0], h1[1], h1[2], h1[3]}, o[d0], 0, 0, 0);   \
        o[d0] = __builtin_amdgcn_mfma_f32_32x32x16_bf16(pa2, (bf16x8){l2[0], l2[1], l2[2], l2[3], h2[0], h2[1], h2[2], h2[3]}, o[d0], 0, 0, 0);   \
        o[d0] = __builtin_amdgcn_mfma_f32_32x32x16_bf16(pa3, (bf16x8){l3[0], l3[1], l3[2], l3[3], h3[0], h3[1], h3[2], h3[3]}, o[d0], 0, 0, 0); } while (0)
    PV_D0(0); PV_D0(1); PV_D0(2); PV_D0(3);
#undef PV_D0
#undef TRRD
}

struct BlockRef { unsigned q, k, v, f, o; int P0; float fref; };
typedef __amdgpu_buffer_rsrc_t rsrc_t;
typedef unsigned u32x4v __attribute__((ext_vector_type(4)));
struct Seam { bf16x8 qr[8]; bf16x8 st_v0, st_v1, st_k0, st_k1; float st_f; };
__device__ __forceinline__ bf16x8 bld8(rsrc_t rs, unsigned voff, unsigned soff) { return __builtin_bit_cast(bf16x8, __builtin_amdgcn_raw_buffer_load_b128(rs, (int)voff, (int)soff, 0)); }
__device__ __forceinline__ float bldf(rsrc_t rs, unsigned voff, unsigned soff) { return __uint_as_float(__builtin_amdgcn_raw_buffer_load_b32(rs, (int)voff, (int)soff, 0)); }
#define ROWS(base, k0, rr) ((base) + (unsigned)(((k0) + (rr)) * RS * 2))
#define VMW() asm volatile("s_waitcnt vmcnt(0)" ::: "memory")
#define VMWN(n) asm volatile("s_waitcnt vmcnt(%0)" :: "i"(n) : "memory")
#define SLOAD_H(Kp, Vp, Fp, k0) do { S.st_v0 = bld8(rs, toff, ROWS(Vp, k0, 0)); S.st_v1 = bld8(rs, toff, ROWS(Vp, k0, 32));              \
                         S.st_k0 = bld8(rs, toff, ROWS(Kp, k0, 0)); S.st_k1 = bld8(rs, toff, ROWS(Kp, k0, 32)); S.st_f = bldf(rs, foff, (Fp) + (unsigned)((k0) * 4)); } while (0)
#define SWRITE_HK(bf, fref_) do { *(bf16x8*)(K_lds + (bf) * SHM_K + kws) = S.st_k0; *(bf16x8*)(K_lds + (bf) * SHM_K + kws + 32 * 256) = S.st_k1; \
                         if (wid == 0) F_lds[(bf) * 64 + lane] = ((fref_) - S.st_f) * INV_SCALE; } while (0)
#define SWRITE_HV(bf) do { *(bf16x8*)(V_lds + (bf) * SHM_V + vst0) = S.st_v0; *(bf16x8*)(V_lds + (bf) * SHM_V + vst1) = S.st_v1; } while (0)
__device__ __forceinline__ void fox_prime(const BlockRef& cur, char* lds, Seam& S, const int tid, const rsrc_t rs) {
    const int wid = __builtin_amdgcn_readfirstlane(tid >> 6), lane = tid & 63, r32 = lane & 31, hi = lane >> 5;
    const int sr = tid >> 4, sc = (tid & 15) * 8, kws = KSWZ(sr, sc * 2); char* K_lds = lds + 2 * SHM_V; float* F_lds = (float*)(lds + OFF_F);
    const unsigned toff = (unsigned)(sr * RS + sc) * 2u, foff = (unsigned)(tid & 63) * 4u, qoff = (unsigned)(r32 * RS + hi * 8) * 2u;
    { const unsigned qs = cur.q + (unsigned)(wid * QBLK * RS * 2);
#pragma unroll
      for (int d0 = 0; d0 < 8; ++d0) S.qr[d0] = bld8(rs, qoff + d0 * 32, qs); }
    SLOAD_H(cur.k, cur.v, cur.f, 0); VMW(); SWRITE_HK(0, cur.fref);
    __syncthreads();
}
__device__ __forceinline__ void fox_block(const BlockRef& cur, const BlockRef& nxt, char* lds, Seam& S, const int tid, const rsrc_t rs) {
    const int wid = __builtin_amdgcn_readfirstlane(tid >> 6), lane = tid & 63, r32 = lane & 31, hi = lane >> 5;
    const int NT = (cur.P0 + QB) / KVBLK;
    const int qlo = cur.P0 + wid * QBLK, qm = qlo + r32 - 4 * hi;
    char* V_lds = lds; char* K_lds = lds + 2 * SHM_V; float* F_lds = (float*)(lds + OFF_F);
    float* ws = (float*)(lds + OFF_WS) + wid * 64; float* li_l = ws, * al_l = ws + 32;
    float m_reg = -1e30f, l_reg = 0; f32x16 o[4] = {};
    const int sr = tid >> 4, sc = (tid & 15) * 8, vst0 = v_st(sr, sc), vst1 = v_st(32 + sr, sc), kws = KSWZ(sr, sc * 2);
    const unsigned toff = (unsigned)(sr * RS + sc) * 2u, foff = (unsigned)(tid & 63) * 4u, qoff = (unsigned)(r32 * RS + hi * 8) * 2u;
    const int vb0 = (int)(uintptr_t)V_lds + v_rd_base(lane);
    const unsigned Kh = cur.k, Vh = cur.v, Fh = cur.f; const float fref = cur.fref;
#define RESC(a) do { if (__any((a) < 1.f)) { if (hi == 0) al_l[r32] = (a); asm volatile("s_waitcnt lgkmcnt(0)" ::: "memory");              \
                     for (int d_ = 0; d_ < 4; ++d_) for (int r = 0; r < 16; ++r) o[d_][r] *= al_l[crow(r, hi)]; } } while (0)
#define KBASE(t) ((t) * KVBLK)
#define MASKT(P0_, P1_, t) do { const int kb_ = KBASE(t); if (kb_ + KVBLK - 1 > qlo) mask_tile(P0_, P1_, qm - kb_); } while (0)
    constexpr int NQL = 8;
#define SEAM_K0() do { VMWN(NQL); SWRITE_HK(0, nxt.fref); SBAR(); } while (0)
    f32x16 pA0, pA1, pB0, pB1; float mnA, mnB, alA, alB; bf16x8 pa0, pa1, pa2, pa3;
    SWRITE_HV(0); SBAR();
    if (NT > 1) SLOAD_H(Kh, Vh, Fh, KBASE(1));
    SBAR(); qkt<0>(pA0, pA1, K_lds, r32, hi, S.qr);
    MASKT(pA0, pA1, 0); partialSM(pA0, pA1, m_reg, mnA, alA);
    if (NT > 1) { VMW(); SWRITE_HV(1); SWRITE_HK(1, fref); }
    __syncthreads();
#define HALF_STEP(PX0, PX1, mnX, alX, PY0, PY1, alY, t, KB, VB, SB) do {                                                      \
        SBAR(); qkt<KB>(PX0, PX1, K_lds, r32, hi, S.qr);                                                                      \
        finishSM(PY0, PY1, alY, l_reg, pa0, pa1, pa2, pa3); SBAR();                                                           \
        if ((t) + 1 < NT) { SLOAD_H(Kh, Vh, Fh, KBASE((t) + 1)); SBAR(); }                                                    \
        pv_tile<VB>(o, vb0, pa0, pa1, pa2, pa3); MASKT(PX0, PX1, (t)); partialSM(PX0, PX1, m_reg, mnX, alX);                  \
        __syncthreads();                                                                                                      \
        if ((t) + 1 < NT) { VMW(); SWRITE_HV(SB); SWRITE_HK(SB, fref); }                                                      \
        RESC(alX); __syncthreads(); } while (0)
    for (int t = 1; t + 1 < NT; t += 2) {
        HALF_STEP(pB0, pB1, mnB, alB, pA0, pA1, alA, t, 1, 0, 0);
        HALF_STEP(pA0, pA1, mnA, alA, pB0, pB1, alB, t + 1, 0, 1, 1);
    }
    SBAR(); qkt<1>(pB0, pB1, K_lds, r32, hi, S.qr); SBAR();
    SLOAD_H(nxt.k, nxt.v, nxt.f, 0); SBAR();
    { const unsigned qs = nxt.q + (unsigned)(wid * QBLK * RS * 2);
#pragma unroll
      for (int d0 = 0; d0 < 8; ++d0) S.qr[d0] = bld8(rs, qoff + d0 * 32, qs); }
    SBAR();
    finishSM(pA0, pA1, alA, l_reg, pa0, pa1, pa2, pa3); SBAR();
    pv_tile<0>(o, vb0, pa0, pa1, pa2, pa3);
    MASKT(pB0, pB1, NT - 1); partialSM(pB0, pB1, m_reg, mnB, alB); __syncthreads(); RESC(alB);
    finishSM(pB0, pB1, alB, l_reg, pa0, pa1, pa2, pa3); SBAR(); pv_tile<1>(o, vb0, pa0, pa1, pa2, pa3);
    SBAR(); SEAM_K0();
    if (hi == 0) li_l[r32] = l_reg; asm volatile("s_waitcnt lgkmcnt(0)" ::: "memory");
    float rli[16];
#pragma unroll
    for (int r = 0; r < 16; ++r) rli[r] = __builtin_amdgcn_rcpf(li_l[crow(r, hi)]);
    const unsigned ooff = (unsigned)(4 * hi * RS + r32) * 2u;
#pragma unroll
    for (int r = 0; r < 16; ++r) { const unsigned os = cur.o + (unsigned)((wid * QBLK + (r & 3) + 8 * (r >> 2)) * RS * 2);
#pragma unroll
        for (int d0 = 0; d0 < 4; ++d0) { const float v = o[d0][r] * rli[r];
            const float vn = __int_as_float(__builtin_amdgcn_update_dpp(0, __float_as_int(v), 0xB1, 0xf, 0xf, true));
            if ((r32 & 1) == 0) __builtin_amdgcn_raw_buffer_store_b32(cvtpk(v, vn), rs, (int)(ooff + d0 * 64), (int)os, 0); } }
    __syncthreads();
#undef RESC
#undef KBASE
#undef MASKT
#undef SEAM_K0
#undef HALF_STEP
}
#undef ROWS
#undef VMW
#undef VMWN
#undef SLOAD_H
#undef SWRITE_HK
#undef SWRITE_HV
#undef KSWZ
#undef SBAR
}

struct Frame {
    LAS unsigned char* lds;
    int tid, lane, wave, vcu, G, gw, NGW, bid;
};
__device__ __forceinline__ Frame relaunder(const Frame& F0) {
    Frame F; F.lds = F0.lds; int w = F0.wave, bx = F0.bid, G = F0.G;
    unsigned ones = ~0u; asm volatile("" : "+s"(ones));
    int ln = (int)__builtin_amdgcn_mbcnt_hi(ones, __builtin_amdgcn_mbcnt_lo(ones, 0u)); asm volatile("" : "+s"(w)); asm volatile("" : "+s"(bx)); asm volatile("" : "+s"(G));
    F.tid = w * 64 + ln; F.lane = ln; F.wave = w; F.bid = bx; F.G = G;
    F.vcu = (G % 8 == 0) ? (bx % 8) * (G / 8) + bx / 8 : bx; F.gw = F.vcu * NWAVES + F.wave; F.NGW = G * NWAVES; return F; }
template <int CTRL> __device__ __forceinline__ float dppf(float v) { return __int_as_float(__builtin_amdgcn_update_dpp(0, __float_as_int(v), CTRL, 0xf, 0xf, true)); }
__device__ __forceinline__ float xor1(float v) { return dppf<0xB1>(v); }
__device__ __forceinline__ float xor2(float v) { return dppf<0x4E>(v); }
__device__ __forceinline__ float bperm(float v, int srclane) { return __int_as_float(__builtin_amdgcn_ds_bpermute(srclane << 2, __float_as_int(v))); }
__device__ __forceinline__ float wave_sum(float v, int lane) {
    v += xor1(v); v += xor2(v); v += dppf<0x124>(v); v += dppf<0x128>(v);
    v += bperm(v, lane ^ 16);
    { auto rr = __builtin_amdgcn_permlane32_swap(__float_as_uint(v), __float_as_uint(v), false, false); v = __uint_as_float(rr[0]) + __uint_as_float(rr[1]); }
    return v;
}
__device__ __forceinline__ float bflo(unsigned w) { return __uint_as_float(w << 16); }
__device__ __forceinline__ float bfhi(unsigned w) { return __uint_as_float(w & 0xffff0000u); }

__device__ __forceinline__ void transpose_item(const float* W, int ldw, bf16* WT, int ldt, int k0, int n0, int drow0, LAS float* scr, int lane) {
#pragma unroll 8
    for (int i = 0; i < 32; ++i) { const int kk = 2 * i + (lane >> 5); scr[kk * 33 + (lane & 31)] = W[(size_t)(k0 + kk) * ldw + n0 + (lane & 31)]; }
    LDS_WAIT(); asm volatile("" ::: "memory");
    const int c = lane & 7;
#pragma unroll
    for (int j = 0; j < 4; ++j) { const int n = (lane >> 3) + 8 * j; const LAS float* s = scr + (8 * c) * 33 + n;
        v4u o; o.x = pk2(s[0 * 33], s[1 * 33]); o.y = pk2(s[2 * 33], s[3 * 33]); o.z = pk2(s[4 * 33], s[5 * 33]); o.w = pk2(s[6 * 33], s[7 * 33]);
        *(GAS v4u*)(WT + (size_t)(drow0 + n) * ldt + k0 + 8 * c) = o; }
    LDS_WAIT(); asm volatile("" ::: "memory");
}
__device__ __forceinline__ void cvt_matrix(const Frame& F0, const float* W, int K, int N, bf16* WT) {
    const Frame F = relaunder(F0);
    LAS float* scr = (LAS float*)(F.lds + F.wave * 16384);
    const int nblk = N / 32, nitems = (K / 64) * nblk;
    for (int it = F.gw; it < nitems; it += F.NGW) { const int kb = it / nblk, nb = it - kb * nblk; transpose_item(W, N, WT, K, 64 * kb, 32 * nb, 32 * nb, scr, F.lane); }
}
__device__ __forceinline__ void cvt_gates(const Frame& F0, const float* wa, const float* wi, bf16* Wg) {
    const Frame F = relaunder(F0);
    LAS float* scr = (LAS float*)(F.lds + F.wave * 16384);
    for (int it = F.gw; it < 512; it += F.NGW) { const int gsel = it >> 8, blk = (it >> 5) & 7, sub = it & 31, kb = sub >> 3, nb = sub & 7, n0 = 32 * nb;
        const float* W = (gsel ? wi : wa) + (size_t)blk * 65536;
        transpose_item(W, 256, Wg, 256, 64 * kb, n0, (2 * blk + (n0 >> 7)) * 256 + gsel * 128 + (n0 & 127), scr, F.lane); }
}
__device__ __forceinline__ void mod_gemv(const Frame& F0, const float* c, const float* w_mod, const float* kv_w_mod, float* MODP) {
    const Frame F = relaunder(F0);
    LAS float* cs = (LAS float*)(F.lds + F.wave * 16384);
    constexpr int NCG = NCOLS_MOD / 256, KR = DM / KSPLIT;
    for (int task = F.gw; task < NCG * KSPLIT; task += F.NGW) {
        const int p = task % KSPLIT, cg = task / KSPLIT, col = cg * 256, k0 = p * KR;
        const float* W; int ldw, cin;
        if (col < NLAYER * 6 * DM) { const int l = col / (6 * DM); W = w_mod + (size_t)l * DM * (6 * DM); ldw = 6 * DM; cin = col - l * 6 * DM; }
        else { W = kv_w_mod; ldw = 2 * DM; cin = col - NLAYER * 6 * DM; }
#pragma unroll
        for (int i = 0; i < 4; ++i)
#pragma unroll
            for (int b = 0; b < 2; ++b) { const float v = GP(const float, c)[b * DM + k0 + F.lane + 64 * i]; cs[b * 256 + F.lane + 64 * i] = v / (1.0f + __expf(-v)); }
        LDS_WAIT(); asm volatile("" ::: "memory");
        f32x4 a0 = {0.f, 0.f, 0.f, 0.f}, a1 = {0.f, 0.f, 0.f, 0.f};
        const float* wp = W + (size_t)k0 * ldw + cin + 4 * F.lane;
#pragma unroll 8
        for (int k = 0; k < KR; ++k) { const f32x4 w = *(const GAS f32x4*)(wp + (size_t)k * ldw); const float s0 = cs[k], s1 = cs[256 + k]; a0 += w * s0; a1 += w * s1; }
        *(GAS f32x4*)(MODP + (size_t)(p * 2 + 0) * NCOLS_MOD + col + 4 * F.lane) = a0;
        *(GAS f32x4*)(MODP + (size_t)(p * 2 + 1) * NCOLS_MOD + col + 4 * F.lane) = a1;
        LDS_WAIT(); asm volatile("" ::: "memory");
    }
}
template <bool WITH_F>
__device__ __forceinline__ void norm_rows(const Frame& F0, const float* x, const float* gain, const float* shift, const float* scale, bf16* out, const float* w_forget, const float* b_forget, float* logf) {
    const Frame F = relaunder(F0);
    LAS float* wfT = (LAS float*)F.lds;
    if (WITH_F) {
#pragma unroll 4
        for (int i = 0; i < 16; ++i) { const int idx = F.tid + 512 * i, d = idx >> 2, j0 = (idx & 3) * 4; const f32x4 v = *(const GAS f32x4*)(w_forget + 4 * idx);
            wfT[(j0 + 0) * DM + d] = v.x; wfT[(j0 + 1) * DM + d] = v.y; wfT[(j0 + 2) * DM + d] = v.z; wfT[(j0 + 3) * DM + d] = v.w; }
        __syncthreads();
    }
    constexpr int RPW = M / 2048;
    for (int r0 = F.gw * RPW; r0 < M; r0 += F.NGW * RPW) {
        const int b = r0 / SEQ;
        f32x4 A[8], Bv[8];
#pragma unroll
        for (int j = 0; j < 8; ++j) { const int d = 4 * (F.lane + 64 * j); const f32x4 g = *(const GAS f32x4*)(gain + d), sc = *(const GAS f32x4*)(scale + (size_t)b * NCOLS_MOD + d);
            A[j] = g * (sc + 1.0f); Bv[j] = *(const GAS f32x4*)(shift + (size_t)b * NCOLS_MOD + d); }
#pragma clang loop unroll(disable)
        for (int r = r0; r < r0 + RPW; ++r) {
            const GAS f32x4* xr = (const GAS f32x4*)(x + (size_t)r * DM) + F.lane;
            f32x4 v[8]; float s = 0.f;
#pragma unroll
            for (int j = 0; j < 8; ++j) { v[j] = xr[64 * j]; s += (v[j].x * v[j].x + v[j].y * v[j].y) + (v[j].z * v[j].z + v[j].w * v[j].w); }
            const float rstd = 1.0f / sqrtf(wave_sum(s, F.lane) * (1.0f / DM) + NORM_EPS);
            GAS unsigned long long* o8 = (GAS unsigned long long*)(out + (size_t)r * DM) + F.lane;
#pragma unroll
            for (int j = 0; j < 8; ++j) { v[j] = (v[j] * rstd) * A[j] + Bv[j]; o8[64 * j] = (unsigned long long)pk2(v[j].x, v[j].y) | ((unsigned long long)pk2(v[j].z, v[j].w) << 32); }
            if (WITH_F) {
                float pt[16];
#pragma unroll
                for (int h = 0; h < 16; ++h) { float a = 0.f;
#pragma unroll
                    for (int j = 0; j < 8; ++j) { const f32x4 w = *(const LAS f32x4*)(wfT + h * DM + 4 * (F.lane + 64 * j)); a += (v[j].x * w.x + v[j].y * w.y) + (v[j].z * w.z + v[j].w * w.w); }
                    pt[h] = a; __builtin_amdgcn_sched_barrier(0); }
#pragma unroll
                for (int i = 0; i < 8; ++i) { const bool up = (F.lane & 32) != 0; const float send = up ? pt[i] : pt[i + 8], keep = up ? pt[i + 8] : pt[i]; pt[i] = keep + bperm(send, F.lane ^ 32); }
#pragma unroll
                for (int i = 0; i < 4; ++i) { const bool up = (F.lane & 16) != 0; const float send = up ? pt[i] : pt[i + 4], keep = up ? pt[i + 4] : pt[i]; pt[i] = keep + bperm(send, F.lane ^ 16); }
#pragma unroll
                for (int i = 0; i < 2; ++i) { const bool up = (F.lane & 8) != 0; const float send = up ? pt[i] : pt[i + 2], keep = up ? pt[i + 2] : pt[i]; pt[i] = keep + bperm(send, F.lane ^ 8); }
                { const bool up = (F.lane & 4) != 0; const float send = up ? pt[0] : pt[1], keep = up ? pt[1] : pt[0]; pt[0] = keep + bperm(send, F.lane ^ 4); }
                pt[0] += xor2(pt[0]); pt[0] += xor1(pt[0]);
                const int h = F.lane >> 2; const float z = pt[0] + GP(const float, b_forget)[h];
                const float lf = fminf(z, 0.f) - log1pf(__expf(-fabsf(z)));
                if ((F.lane & 3) == 0) GP(float, logf)[(size_t)r * 16 + h] = lf;
            }
        }
    }
    if (WITH_F) __syncthreads();
}
__device__ __forceinline__ void headnorm_rows(const Frame& F0, const bf16* src, bf16* dst, const float* g) {
    const Frame F = relaunder(F0);
    float gg[32];
#pragma unroll
    for (int i = 0; i < 32; ++i) gg[i] = GP(const float, g)[32 * (F.lane & 3) + i];
    for (int r = F.gw; r < M; r += F.NGW) {
        const GAS v4u* sp = (const GAS v4u*)(src + (size_t)r * DM + 32 * F.lane);
        v4u w[4]; float xv[32]; float s = 0.f;
#pragma unroll
        for (int q = 0; q < 4; ++q) w[q] = sp[q];
#pragma unroll
        for (int q = 0; q < 4; ++q) { xv[8 * q + 0] = bflo(w[q].x); xv[8 * q + 1] = bfhi(w[q].x); xv[8 * q + 2] = bflo(w[q].y); xv[8 * q + 3] = bfhi(w[q].y);
            xv[8 * q + 4] = bflo(w[q].z); xv[8 * q + 5] = bfhi(w[q].z); xv[8 * q + 6] = bflo(w[q].w); xv[8 * q + 7] = bfhi(w[q].w); }
#pragma unroll
        for (int i = 0; i < 32; ++i) s += xv[i] * xv[i];
        s += xor1(s); s += xor2(s);
        const float rstd = 1.0f / sqrtf(s * (1.0f / DH) + NORM_EPS);
        GAS v4u* dp = (GAS v4u*)(dst + (size_t)r * DM + 32 * F.lane);
#pragma unroll
        for (int q = 0; q < 4; ++q) { v4u o; o.x = pk2(xv[8 * q + 0] * rstd * gg[8 * q + 0], xv[8 * q + 1] * rstd * gg[8 * q + 1]); o.y = pk2(xv[8 * q + 2] * rstd * gg[8 * q + 2], xv[8 * q + 3] * rstd * gg[8 * q + 3]);
            o.z = pk2(xv[8 * q + 4] * rstd * gg[8 * q + 4], xv[8 * q + 5] * rstd * gg[8 * q + 5]); o.w = pk2(xv[8 * q + 6] * rstd * gg[8 * q + 6], xv[8 * q + 7] * rstd * gg[8 * q + 7]); dp[q] = o; }
    }
}
__device__ __forceinline__ void cumsum_F(const Frame& F0, const float* logf, float* Fo) {
    const Frame F = relaunder(F0);
    LAS float* wt = (LAS float*)F.lds;
    for (int bh = F.bid; bh < BATCH * NH; bh += F.G) {
        const int b = bh / NH, h = bh % NH, s0 = 32 * F.tid;
        float v[32]; float tot = 0.f;
#pragma unroll
        for (int i = 0; i < 32; ++i) { v[i] = GP(const float, logf)[((size_t)b * SEQ + s0 + i) * 16 + h]; tot += v[i]; }
        float inc = tot;
#pragma unroll
        for (int o = 1; o < 64; o <<= 1) { const float t = bperm(inc, F.lane - o); if (F.lane >= o) inc += t; }
        if (F.lane == 63) wt[F.wave] = inc;
        __syncthreads();
        float off = inc - tot;
        for (int w = 0; w < F.wave; ++w) off += wt[w];
        float run = off;
#pragma unroll
        for (int i = 0; i < 32; ++i) { run += v[i]; GP(float, Fo)[(size_t)bh * SEQ + s0 + i] = run; }
        __syncthreads();
    }
}
__device__ __forceinline__ void conv_rows(const Frame& F0, const bf16* xb, const float* cw, const float* cb, bf16* xc) {
    const Frame F = relaunder(F0);
    constexpr int RB = 32, NT = (M / RB) * 4;
    for (int task = F.gw; task < NT; task += F.NGW) {
        const int rb = task >> 2, ch = (task & 3) * 512 + F.lane * 8, r0 = rb * RB;
        float w[4][8], bb[8];
#pragma unroll
        for (int k = 0; k < 4; ++k) { const f32x4 a = *(const GAS f32x4*)(cw + k * DM + ch), c2 = *(const GAS f32x4*)(cw + k * DM + ch + 4);
            w[k][0] = a.x; w[k][1] = a.y; w[k][2] = a.z; w[k][3] = a.w; w[k][4] = c2.x; w[k][5] = c2.y; w[k][6] = c2.z; w[k][7] = c2.w; }
        { const f32x4 a = *(const GAS f32x4*)(cb + ch), c2 = *(const GAS f32x4*)(cb + ch + 4); bb[0] = a.x; bb[1] = a.y; bb[2] = a.z; bb[3] = a.w; bb[4] = c2.x; bb[5] = c2.y; bb[6] = c2.z; bb[7] = c2.w; }
        const bool head = (r0 % SEQ) == 0;
        v4u hw[3];
#pragma unroll
        for (int k = 0; k < 3; ++k) hw[k] = head ? (v4u){0u, 0u, 0u, 0u} : *(const GAS v4u*)(xb + (size_t)(r0 - 3 + k) * DM + ch);
        float x0[8], x1[8], x2[8];
#define UNPK(dst, ww) do { dst[0] = bflo(ww.x); dst[1] = bfhi(ww.x); dst[2] = bflo(ww.y); dst[3] = bfhi(ww.y); dst[4] = bflo(ww.z); dst[5] = bfhi(ww.z); dst[6] = bflo(ww.w); dst[7] = bfhi(ww.w); } while (0)
        UNPK(x0, hw[0]); UNPK(x1, hw[1]); UNPK(x2, hw[2]);
        for (int rr = 0; rr < RB; rr += 8) {
            v4u in[8];
#pragma unroll
            for (int q = 0; q < 8; ++q) in[q] = *(const GAS v4u*)(xb + (size_t)(r0 + rr + q) * DM + ch);
#pragma unroll
            for (int q = 0; q < 8; ++q) { float x3[8], y[8]; UNPK(x3, in[q]);
#pragma unroll
                for (int e = 0; e < 8; ++e) { y[e] = bb[e] + w[0][e] * x0[e] + w[1][e] * x1[e] + w[2][e] * x2[e] + w[3][e] * x3[e]; x0[e] = x1[e]; x1[e] = x2[e]; x2[e] = x3[e]; }
                v4u o; o.x = pk2(y[0], y[1]); o.y = pk2(y[2], y[3]); o.z = pk2(y[4], y[5]); o.w = pk2(y[6], y[7]);
                *(GAS v4u*)(xc + (size_t)(r0 + rr + q) * DM + ch) = o; }
        }
#undef UNPK
    }
}
__device__ __forceinline__ void scan_local(const Frame& F0, const float* Aa, const float* Uu, float* Pc, float* Hc) {
    const Frame F = relaunder(F0);
    for (int task = F.gw; task < NCHUNK * 8; task += F.NGW) {
        const int cr = task >> 3, ch = (task & 7) * 256 + F.lane * 4; const size_t base = (size_t)cr * CHUNK * DM + ch;
        f32x4 h = {0.f, 0.f, 0.f, 0.f}, P = {1.f, 1.f, 1.f, 1.f};
        for (int t = 0; t < CHUNK; t += 8) {
            f32x4 a[8], u[8];
#pragma unroll
            for (int q = 0; q < 8; ++q) { a[q] = *(const GAS f32x4*)(Aa + base + (size_t)(t + q) * DM); u[q] = *(const GAS f32x4*)(Uu + base + (size_t)(t + q) * DM); }
#pragma unroll
            for (int q = 0; q < 8; ++q) { h = a[q] * h + u[q]; P = P * a[q]; }
        }
        *(GAS f32x4*)(Pc + (size_t)cr * DM + ch) = P; *(GAS f32x4*)(Hc + (size_t)cr * DM + ch) = h;
    }
}
__device__ __forceinline__ void scan_carry(const Frame& F0, const float* Pc, const float* Hc, float* Cy) {
    const Frame F = relaunder(F0);
    if (F.wave != 0) return;
    for (int task = F.vcu; task < BATCH * (DM / 64); task += F.G) {
        const int b = task / (DM / 64), ch = (task % (DM / 64)) * 64 + F.lane; const int cr0 = b * (NCHUNK / BATCH);
        float h = 0.f;
        for (int c0 = 0; c0 < NCHUNK / BATCH; c0 += 16) {
            float p[16], q[16];
#pragma unroll
            for (int i = 0; i < 16; ++i) { p[i] = GP(const float, Pc)[(size_t)(cr0 + c0 + i) * DM + ch]; q[i] = GP(const float, Hc)[(size_t)(cr0 + c0 + i) * DM + ch]; }
#pragma unroll
            for (int i = 0; i < 16; ++i) { GP(float, Cy)[(size_t)(cr0 + c0 + i) * DM + ch] = h; h = p[i] * h + q[i]; }
        }
    }
}
__device__ __forceinline__ void scan_fix(const Frame& F0, const float* Aa, const float* Uu, const float* Cy, const bf16* yg, bf16* hs) {
    const Frame F = relaunder(F0);
    for (int task = F.gw; task < NCHUNK * 8; task += F.NGW) {
        const int cr = task >> 3, ch = (task & 7) * 256 + F.lane * 4; const size_t base = (size_t)cr * CHUNK * DM + ch;
        f32x4 h = *(const GAS f32x4*)(Cy + (size_t)cr * DM + ch);
        for (int t = 0; t < CHUNK; t += 8) {
            f32x4 a[8], u[8]; unsigned long long g[8];
#pragma unroll
            for (int q = 0; q < 8; ++q) { a[q] = *(const GAS f32x4*)(Aa + base + (size_t)(t + q) * DM); u[q] = *(const GAS f32x4*)(Uu + base + (size_t)(t + q) * DM); g[q] = *(const GAS unsigned long long*)(yg + base + (size_t)(t + q) * DM); }
#pragma unroll
            for (int q = 0; q < 8; ++q) { h = a[q] * h + u[q]; const unsigned g0 = (unsigned)g[q], g1 = (unsigned)(g[q] >> 32);
                *(GAS unsigned long long*)(hs + base + (size_t)(t + q) * DM) = (unsigned long long)pk2(h.x * bflo(g0), h.y * bfhi(g0)) | ((unsigned long long)pk2(h.z * bflo(g1), h.w * bfhi(g1)) << 32); }
        }
    }
}
__device__ __forceinline__ fox::BlockRef fox_ref(int L, int pass, const unsigned char* ws, unsigned oQ, unsigned oK, unsigned oV, unsigned oF, unsigned oO) {
    const int xcd = L & 7, k = L >> 3, gi = k >> 5, x = k & 31, bh = gi * 8 + xcd, b = bh >> 4, h = bh & 15, qb = pass ? 63 - x : x;
    const unsigned rowb = (unsigned)(((size_t)b * SEQ * DM + (size_t)h * DH) * 2), qrow = (unsigned)((size_t)qb * 256 * DM * 2);
    fox::BlockRef r; r.q = oQ + rowb + qrow; r.o = oO + rowb + qrow; r.k = oK + rowb; r.v = oV + rowb; r.f = oF + (unsigned)(bh * SEQ * 4); r.P0 = qb * 256;
    r.fref = __uint_as_float(__builtin_amdgcn_readfirstlane(__float_as_uint(*(const GAS float*)((const GAS unsigned char*)ws + r.f + (unsigned)((qb * 256 + 255) * 4)))));
    return r;
}
__device__ __forceinline__ void attn_phase(const Frame& F0, char* lds, const unsigned char* ws, unsigned oQ, unsigned oK, unsigned oV, unsigned oF, unsigned oO) {
    const Frame F = relaunder(F0);
    constexpr int NITEM = BATCH * NH * 32;
    int L = F.bid; if (L >= NITEM) return;
    const fox::rsrc_t rs = __builtin_amdgcn_make_buffer_rsrc((void*)ws, (short)0, (int)WS_END, 0x00020000);
    int pass = 0;
    fox::BlockRef cur = fox_ref(L, 0, ws, oQ, oK, oV, oF, oO);
    fox::Seam S;
    fox::fox_prime(cur, lds, S, F.tid, rs);
    for (;;) {
        const bool more_pass = pass == 0, more_item = L + F.G < NITEM, last = !more_pass && !more_item;
        int passn = pass + 1, Ln = L;
        if (!more_pass) { passn = 0; Ln = more_item ? L + F.G : L; }
        const fox::BlockRef nxt = last ? cur : fox_ref(Ln, passn, ws, oQ, oK, oV, oF, oO);
        fox::fox_block(cur, nxt, lds, S, F.tid, rs);
        if (last) break;
        cur = nxt; pass = passn; L = Ln;
    }
}

struct Args { const float* in[27]; float* out; unsigned char* ws; };
constexpr int PTAB_OFF = LDSCTL_OFF + 1024;
__device__ __forceinline__ unsigned long long ptab(LAS unsigned char* lds, int i) {
    LAS unsigned char* p = lds + PTAB_OFF; asm volatile("" : "+v"(p));
    const unsigned long long v = ((const LAS unsigned long long*)p)[i];
    const unsigned lo = __builtin_amdgcn_readfirstlane((unsigned)v), hi = __builtin_amdgcn_readfirstlane((unsigned)(v >> 32));
    return ((unsigned long long)hi << 32) | lo;
}
#define IN(k) ((const float*)ptab(F.lds, (k)))
#define XO() ((float*)ptab(F.lds, 27))
#define WSP(off) ((unsigned char*)ptab(F.lds, 28) + (off))
__global__ void __launch_bounds__(NWAVES * 64, 2) yoco_fwd(Args args) {
    extern __shared__ __attribute__((aligned(16))) unsigned char lds[];
    Frame F;
    F.lds = (LAS unsigned char*)lds;
    volatile LAS unsigned* MISC = (volatile LAS unsigned*)(F.lds + MISC_OFF);
    F.tid = threadIdx.x; F.lane = F.tid & 63; F.wave = __builtin_amdgcn_readfirstlane(F.tid >> 6); F.bid = blockIdx.x;
    F.G = gridDim.x; { const int bx = blockIdx.x; F.vcu = (F.G % 8 == 0) ? (bx % 8) * (F.G / 8) + bx / 8 : bx; }
    F.gw = F.vcu * NWAVES + F.wave; F.NGW = F.G * NWAVES;
    for (int u = F.tid; u < (LDS_BYTES - LDSCTL_OFF) / 4; u += NWAVES * 64) ((LAS unsigned*)(F.lds + LDSCTL_OFF))[u] = 0u;
    __syncthreads();
    if (F.tid == 0) { LAS unsigned long long* t = (LAS unsigned long long*)(F.lds + PTAB_OFF);
#pragma unroll
        for (int i = 0; i < 27; ++i) t[i] = (unsigned long long)args.in[i];
        t[27] = (unsigned long long)args.out; t[28] = (unsigned long long)args.ws; }
    __syncthreads();
    (void)xcd_barrier_post((unsigned*)(WSP(WS_CTL)) + CW_BAR, MISC + 8);
#define GRID_BAR() do { XcdBarrier b_; b_.bar = (unsigned*)(WSP(WS_CTL)) + CW_BAR; b_.x = xb_xcc_id(); b_.st = MISC + 8; xcd_barrier(b_); } while (0)
#define P_MODP ((float*)WSP(WS_MODP))
#define P_MOD ((float*)WSP(WS_MOD))
#define P_C8 ((float*)WSP(WS_C8))
#define P_LOGF ((float*)WSP(WS_LOGF))
#define P_FC ((float*)WSP(WS_F))
#define P_PC ((float*)WSP(WS_PC))
#define P_HC ((float*)WSP(WS_HC))
#define P_CY ((float*)WSP(WS_CARRY))
#define P_W_IN ((bf16*)WSP(WS_WMLP_IN))
#define P_W_OUT ((bf16*)WSP(WS_WMLP_OUT))
#define P_W_MA ((bf16*)WSP(WS_WMIX))
#define P_W_M8 ((bf16*)WSP(WS_WMIX + 8 * MiB))
#define P_W_MB ((bf16*)WSP(WS_WMIX_B))
#define P_W_MC ((bf16*)WSP(WS_WMIX_C))
#define P_H ((bf16*)WSP(WS_H))
#define P_HID ((bf16*)WSP(WS_R1))
#define P_AA ((float*)WSP(WS_R1))
#define P_UU ((float*)WSP(WS_R1 + 256 * MiB))
#define P_KRAW ((bf16*)WSP(WS_R1))
#define P_R2A ((bf16*)WSP(WS_R2A))
#define P_R2B ((bf16*)WSP(WS_R2B))
#define P_R2C ((bf16*)WSP(WS_R2C))
#define P_KB ((bf16*)WSP(WS_K))
#define P_VB ((bf16*)WSP(WS_V))

    mod_gemv(F, IN(1), IN(4), IN(18), P_MODP);
    cvt_matrix(F, IN(6), DM, FF, P_W_IN); cvt_matrix(F, IN(7), FF, DM, P_W_OUT);
    cvt_matrix(F, IN(8), DM, 2 * DM, P_W_MA); cvt_matrix(F, IN(16), DM, DM, P_W_MB); cvt_gates(F, IN(11), IN(13), P_W_MC);
    GRID_BAR();
    { const float* b_mod = IN(5); const float* kv_b_mod = IN(19); const float* lam = IN(15); const float* MODP = P_MODP; float* MOD = P_MOD; float* C8 = P_C8;
      const Frame FL = relaunder(F);
      for (int i = FL.bid * (NWAVES * 64) + FL.tid; i < 2 * NCOLS_MOD; i += FL.G * NWAVES * 64) {
        const int b = i / NCOLS_MOD, col = i - b * NCOLS_MOD; float s = col < NLAYER * 6 * DM ? GP(const float, b_mod)[col] : GP(const float, kv_b_mod)[col - NLAYER * 6 * DM];
#pragma unroll
        for (int p = 0; p < KSPLIT; ++p) s += GP(const float, MODP)[(size_t)(p * 2 + b) * NCOLS_MOD + col];
        GP(float, MOD)[i] = s;
        if (i < NA * DM) GP(float, C8)[i] = -8.0f * log1pf(__expf(-GP(const float, lam)[i]));
      } }
    GRID_BAR();

#pragma clang loop unroll(disable)
    for (int layer = 0; layer < NLAYER; ++layer) {
#define MODL (P_MOD + layer * 6 * DM)
#define XSRC (layer == 0 ? IN(0) : (const float*)XO())
        if (layer > 0) {
            cvt_matrix(F, IN(6) + (size_t)layer * DM * FF, DM, FF, P_W_IN); cvt_matrix(F, IN(7) + (size_t)layer * DM * FF, FF, DM, P_W_OUT);
            if (layer < NA) { cvt_matrix(F, IN(8) + (size_t)layer * DM * 2 * DM, DM, 2 * DM, P_W_MA); cvt_matrix(F, IN(16) + (size_t)layer * DM * DM, DM, DM, P_W_MB);
                cvt_gates(F, IN(11) + (size_t)layer * 8 * 65536, IN(13) + (size_t)layer * 8 * 65536, P_W_MC); }
            else { cvt_matrix(F, IN(24) + (size_t)(layer - NA) * DM * DM, DM, DM, P_W_MA); cvt_matrix(F, IN(26) + (size_t)(layer - NA) * DM * DM, DM, DM, P_W_M8);
                if (layer == NA) cvt_matrix(F, IN(20), DM, 2 * DM, P_W_MB); }
            __syncthreads();
        }
        if (layer == NA) norm_rows<true>(F, XSRC, IN(17), P_MOD + NLAYER * 6 * DM, P_MOD + NLAYER * 6 * DM + DM, P_R2C, IN(22), IN(23), P_LOGF);
        norm_rows<false>(F, XSRC, IN(2) + layer * DM, MODL, MODL + DM, P_H, nullptr, nullptr, nullptr);
        GRID_BAR();
        if (layer < NA) {
            { const Frame FL = relaunder(F); pg8::Gemm g{P_H, P_W_MA, DM, DM, DM, 0}; pg8::StaticOrder S; S.init(M, 2 * DM, FL.G, FL.bid);
              pg8::EpiBf16<1> E{P_R2A, DM, 8, (size_t)(WS_R2B - WS_R2A) / 2, 8};
              pg8::gemm_phase(F.lds, g, S, E, FL.tid); }
            GRID_BAR();
            conv_rows(F, P_R2A, IN(9) + (size_t)layer * 4 * DM, IN(10) + (size_t)layer * DM, P_R2C);
            GRID_BAR();
            { const Frame FL = relaunder(F); pg8::Gemm g{P_R2C, P_W_MC, DM, 256, 256, 2}; pg8::StaticOrder S; S.init(M, 16 * 256, FL.G, FL.bid);
              pg8::EpiGate E{P_R2C, IN(12) + (size_t)layer * DM, IN(14) + (size_t)layer * DM, P_C8 + layer * DM, P_AA, P_UU};
              pg8::gemm_phase(F.lds, g, S, E, FL.tid); }
            GRID_BAR();
            scan_local(F, P_AA, P_UU, P_PC, P_HC);
            GRID_BAR();
            scan_carry(F, P_PC, P_HC, P_CY);
            GRID_BAR();
            scan_fix(F, P_AA, P_UU, P_CY, P_R2B, P_R2A);
            GRID_BAR();
        } else {
            if (layer == NA) { const Frame FL = relaunder(F); pg8::Gemm g{P_R2C, P_W_MB, DM, DM, DM, 0}; pg8::StaticOrder S; S.init(M, 2 * DM, FL.G, FL.bid);
              pg8::EpiBf16<0> E{P_KRAW, DM, 8, (size_t)(WS_V - WS_R1) / 2, 0};
              pg8::gemm_phase(F.lds, g, S, E, FL.tid); }
            { const Frame FL = relaunder(F); pg8::Gemm g{P_H, P_W_MA, DM, DM, DM, 0}; pg8::StaticOrder S; S.init(M, DM, FL.G, FL.bid);
              pg8::EpiBf16<0> E{P_R2A, DM, 0, 0, 0};
              pg8::gemm_phase(F.lds, g, S, E, FL.tid); }
            GRID_BAR();
            if (layer == NA) { cumsum_F(F, P_LOGF, P_FC); headnorm_rows(F, P_KRAW, P_KB, IN(21)); }
            headnorm_rows(F, P_R2A, P_R2B, IN(25) + (size_t)(layer - NA) * DH);
            GRID_BAR();
            attn_phase(F, (char*)lds, WSP(0), (unsigned)WS_R2B, (unsigned)WS_K, (unsigned)WS_V, (unsigned)WS_F, (unsigned)WS_R2C);
            GRID_BAR();
        }
        { const bf16* Ain = layer < NA ? P_R2A : P_R2C; const bf16* Wt = layer < NA ? P_W_MB : P_W_M8;
          const Frame FL = relaunder(F); pg8::Gemm g{Ain, Wt, DM, DM, DM, 0}; pg8::StaticOrder S; S.init(M, DM, FL.G, FL.bid);
          pg8::EpiResid E{XSRC, XO(), MODL + 2 * DM};
          pg8::gemm_phase(F.lds, g, S, E, FL.tid); }
        GRID_BAR();
        norm_rows<false>(F, XO(), IN(3) + layer * DM, MODL + 3 * DM, MODL + 4 * DM, P_H, nullptr, nullptr, nullptr);
        GRID_BAR();
        { const Frame FL = relaunder(F); pg8::Gemm g{P_H, P_W_IN, DM, DM, DM, 0}; pg8::StaticOrder S; S.init(M, FF, FL.G, FL.bid);
          pg8::EpiBf16<2> E{P_HID, FF, 0, 0, 0};
          pg8::gemm_phase(F.lds, g, S, E, FL.tid); }
        GRID_BAR();
        { const Frame FL = relaunder(F); pg8::Gemm g{P_HID, P_W_OUT, FF, FF, FF, 0}; pg8::StaticOrder S; S.init(M, DM, FL.G, FL.bid);
          pg8::EpiResid E{XO(), XO(), MODL + 5 * DM};
          pg8::gemm_phase(F.lds, g, S, E, FL.tid); }
        if (layer + 1 < NLAYER) GRID_BAR();
    }
#undef GRID_BAR
}

extern "C" void kernel_launch(void* const* d_in, const int* in_sizes, int n_in, void* d_out, int out_size, void* d_ws, size_t ws_size, hipStream_t stream) {
    static int grid = 0;
    if (grid == 0) {
        if (n_in != 27 || in_sizes[0] != M * DM || out_size != M * DM || ws_size < WS_END) { fprintf(stderr, "kernel_launch: unexpected shapes (n_in %d, in0 %d, out %d, ws %zu); nothing launched\n", n_in, n_in > 0 ? in_sizes[0] : -1, out_size, ws_size); grid = -1; return; }
        int dev = 0, cus = 0, per_cu = 0;
        if (hipGetDevice(&dev) != hipSuccess || hipDeviceGetAttribute(&cus, hipDeviceAttributeMultiprocessorCount, dev) != hipSuccess) { grid = -1; return; }
        if (hipFuncSetAttribute((const void*)yoco_fwd, hipFuncAttributeMaxDynamicSharedMemorySize, LDS_BYTES) != hipSuccess) { fprintf(stderr, "kernel_launch: hipFuncSetAttribute failed\n"); grid = -1; return; }
        if (hipOccupancyMaxActiveBlocksPerMultiprocessor(&per_cu, (const void*)yoco_fwd, NWAVES * 64, LDS_BYTES) != hipSuccess || per_cu < 1) { fprintf(stderr, "kernel_launch: occupancy query says %d\n", per_cu); }
        (void)hipGetLastError();
        grid = cus;
    }
    if (grid < 0) return;
    if (hipMemsetAsync((char*)d_ws + WS_CTL, 0, CTL_ZERO_BYTES, stream) != hipSuccess) return;
    Args a{};
    for (int i = 0; i < 27; ++i) a.in[i] = (const float*)d_in[i];
    a.out = (float*)d_out; a.ws = (unsigned char*)d_ws;
    hipLaunchKernelGGL(yoco_fwd, dim3(grid), dim3(NWAVES * 64), LDS_BYTES, stream, a);
}
```

```cpp
#include <hip/hip_runtime.h>
#include <hip/hip_bf16.h>
#include <cstdio>
#include <cstdint>

constexpr int BATCH = 2, SEQ = 16384, DM = 2048, FF = 8192, NH = 16, DH = 128, NLAYER = 4, NA = 2;
constexpr int M = BATCH * SEQ;
constexpr float NORM_EPS = 1e-6f;
constexpr int NCOLS_MOD = NLAYER * 6 * DM + 2 * DM;
constexpr int KSPLIT = 8;
constexpr int NWAVES = 8;
constexpr int MLP_SPLIT = 1;
constexpr int CHUNK = 64;
constexpr int NCHUNK = M / CHUNK;

constexpr size_t MiB = 1u << 20;
constexpr size_t WS_CTL = 0, CTL_ZERO_BYTES = 1 * MiB;
constexpr size_t WS_MODP = 1 * MiB;
constexpr size_t WS_MOD = 5 * MiB;
constexpr size_t WS_C8 = 6 * MiB;
constexpr size_t WS_LOGF = 7 * MiB;
constexpr size_t WS_F = 9 * MiB;
constexpr size_t WS_PC = 11 * MiB, WS_HC = 15 * MiB, WS_CARRY = 19 * MiB;
constexpr size_t WS_WMLP_IN = 24 * MiB;
constexpr size_t WS_WMLP_OUT = 56 * MiB;
constexpr size_t WS_WMIX = 88 * MiB;
constexpr size_t WS_WMIX_B = WS_WMIX + 16 * MiB, WS_WMIX_C = WS_WMIX + 24 * MiB;
constexpr size_t WS_WKV = WS_WMIX + 16 * MiB;
constexpr size_t WS_H = 128 * MiB;
constexpr size_t WS_R1 = 256 * MiB;
constexpr size_t WS_R2A = 768 * MiB;
constexpr size_t WS_R2B = 896 * MiB;
constexpr size_t WS_R2C = 1024 * MiB;
constexpr size_t WS_K = 1152 * MiB, WS_V = 1280 * MiB;
constexpr size_t WS_END = 1408 * MiB;
constexpr size_t WS_DESC = 6 * MiB + 256 * 1024;
constexpr int CW_Q = 2048;
constexpr int CW_BAR = 4096;

constexpr int RING_BYTES = 131072;
constexpr int LDSCTL_OFF = RING_BYTES, MISC_OFF = LDSCTL_OFF + 320;
constexpr int XCH_OFF = LDSCTL_OFF + 2048;
constexpr int LDS_BYTES = 147456;

#define GAS __attribute__((address_space(1)))
#define LAS __attribute__((address_space(3)))
typedef unsigned short bf16;
typedef unsigned v4u __attribute__((ext_vector_type(4)));
typedef float f32x4 __attribute__((ext_vector_type(4)));
typedef short bf16x8 __attribute__((ext_vector_type(8)));
typedef GAS unsigned gu32;
typedef GAS unsigned long long gu64;
#define GP(T, p) ((GAS T*)(p))
#define RLX_AGENT __ATOMIC_RELAXED, __HIP_MEMORY_SCOPE_AGENT
#define LDS_WAIT() asm volatile("s_waitcnt lgkmcnt(0)" ::: "memory")
#define VM_WAIT() asm volatile("s_waitcnt vmcnt(0)" ::: "memory")
__device__ __forceinline__ unsigned long long rt() { return __builtin_amdgcn_s_memrealtime(); }
__device__ __forceinline__ unsigned f2bf(float f) { unsigned u = __builtin_bit_cast(unsigned, f); return (u + 0x7fffu + ((u >> 16) & 1u)) >> 16; }
__device__ __forceinline__ unsigned pk2(float lo, float hi) { return f2bf(lo) | (f2bf(hi) << 16); }

#define XB_TMO      128
#define XB_XCNT(j)  (256  + 64 * (j))
#define XB_XSUB(j)  (1280 + 64 * (j))
#define XB_XGEN(j)  (2304 + 64 * (j))
#define XB_TOP      3328
#define XB_TOPGEN   3392
#define XCD_BAR_WORDS 3456
#define XB_SPIN_CAP (1u << 18)

__device__ __forceinline__ unsigned xb_ld(unsigned* p)              { return __hip_atomic_load(p, __ATOMIC_RELAXED, __HIP_MEMORY_SCOPE_AGENT); }
__device__ __forceinline__ unsigned xb_add(unsigned* p, unsigned v) { return __hip_atomic_fetch_add(p, v, __ATOMIC_RELAXED, __HIP_MEMORY_SCOPE_AGENT); }
__device__ __forceinline__ unsigned xb_xcc_id() { return (unsigned)__builtin_amdgcn_s_getreg((3 << 11) | 20) & 0xFu; }
#define XB_SPIN(cond, bar) do { unsigned _sp = 0; while (cond) { __builtin_amdgcn_s_sleep(1); \
    if ((++_sp & 255u) == 0u) { if (xb_ld(&(bar)[XB_TMO])) break; if (_sp > XB_SPIN_CAP) { atomicAdd(&(bar)[XB_TMO], 1u); break; } } } } while (0)

struct XcdBarrier {
    unsigned* bar; unsigned x;
    volatile LAS unsigned* st;
};

__device__ __forceinline__ XcdBarrier xcd_barrier_post(unsigned* bar, volatile LAS unsigned* st) {
    XcdBarrier b; b.bar = bar; b.x = xb_xcc_id(); b.st = st;
    if (threadIdx.x == 0) (void)xb_add(&bar[XB_XCNT(b.x)], 1u);
    return b;
}
__device__ __forceinline__ void xcd_barrier_complete(unsigned* bar, unsigned x, unsigned& nloc, unsigned& nx) {
    const unsigned G = gridDim.x * gridDim.y * gridDim.z;
    unsigned sum, cnt, mine, sp = 0u;
    for (;;) {
        sum = 0u; cnt = 0u; mine = 0u;
#pragma unroll
        for (unsigned j = 0; j < 16; ++j) { const unsigned c = xb_ld(&bar[XB_XCNT(j)]); sum += c; cnt += (c > 0u) ? 1u : 0u; mine = (j == x) ? c : mine; }
        if (sum == G) break;
        __builtin_amdgcn_s_sleep(1);
        if ((++sp & 255u) == 0u) { if (xb_ld(&bar[XB_TMO])) break; if (sp > XB_SPIN_CAP) { atomicAdd(&bar[XB_TMO], 1u); break; } }
    }
    nloc = mine > 0u ? mine : 1u; nx = cnt > 0u ? cnt : 1u;
}

__device__ __forceinline__ void xcd_barrier(const XcdBarrier& b) {
    asm volatile("s_waitcnt vmcnt(0)" ::: "memory");
    __syncthreads();
    if (threadIdx.x == 0) {
        unsigned* bar = b.bar;
        __builtin_amdgcn_s_waitcnt(0);
        unsigned nloc = b.st[0], nx = b.st[1];
        if (nloc == 0u) { xcd_barrier_complete(bar, b.x, nloc, nx); b.st[0] = nloc; b.st[1] = nx; }
        const unsigned old = xb_add(&bar[XB_XSUB(b.x)], 1u);
        const unsigned gen = old / nloc;
        if (old + 1u == (gen + 1u) * nloc) {
            __builtin_amdgcn_fence(__ATOMIC_RELEASE, "agent");
            asm volatile("s_waitcnt vmcnt(0)" ::: "memory");
            const unsigned og = xb_add(&bar[XB_TOP], 1u);
            const unsigned tg = og / nx;
            if (og + 1u == (tg + 1u) * nx) xb_add(&bar[XB_TOPGEN], 1u);
            else XB_SPIN(xb_ld(&bar[XB_TOPGEN]) == tg, bar);
            __builtin_amdgcn_fence(__ATOMIC_ACQUIRE, "agent");
            xb_add(&bar[XB_XGEN(b.x)], 1u);
            asm volatile("s_waitcnt vmcnt(0)" ::: "memory");
        } else {
            XB_SPIN(xb_ld(&bar[XB_XGEN(b.x)]) == gen, bar);
            __builtin_amdgcn_fence(__ATOMIC_ACQUIRE, "agent");
            asm volatile("s_waitcnt vmcnt(0)" ::: "memory");
        }
    }
    __syncthreads();
}

namespace pg8 {
#define PG8_LAS __attribute__((address_space(3)))
#define PG8_GAS __attribute__((address_space(1)))
typedef unsigned short bf16_t;
typedef short bf16x8 __attribute__((ext_vector_type(8)));
typedef float f32x4 __attribute__((ext_vector_type(4)));
typedef float f32x2 __attribute__((ext_vector_type(2)));
typedef unsigned u32x4 __attribute__((ext_vector_type(4)));
typedef unsigned u32x2 __attribute__((ext_vector_type(2)));
constexpr int BM = 256, BK = 64, HALF = 128, HTB = HALF * BK * 2, STAGE_BYTES = 8 * HTB, NXCD = 8, WGM = 8;

__host__ __device__ __forceinline__ int lds_byte(int r, int c) { const int st = (r >> 4) * 2 + (c >> 5), rr = r & 15, cc = c & 31, ob = rr * 64 + cc * 2; return st * 1024 + (ob ^ (((ob >> 9) & 1) << 5)); }
__host__ __device__ __forceinline__ void stage_rc(int b, int& R, int& C) { const int st = b / 1024, sb = b % 1024, swz = sb ^ (((sb >> 9) & 1) << 5); R = (st >> 1) * 16 + swz / 64; C = (st & 1) * 32 + (swz % 64) / 2; }
__host__ __device__ __forceinline__ int perm32(int rho) { const int n = rho >> 4, i = rho & 15; return 8 * (i >> 2) + 4 * n + (i & 3); }

struct Unit { int pm, pn; };
struct Gemm { const bf16_t* A; const bf16_t* Bt; int lda, ldb, K, adiv; int atile = 0; };

struct StaticOrder {
    int nM, nN, nwg, G, c, wgm;
    __host__ __device__ void init(int M_, int N_, int G_, int c_, int wgm_ = WGM) { nM = M_ / BM; nN = N_ / BM; nwg = nM * nN; G = G_; c = c_; wgm = wgm_; }
    __host__ __device__ bool next(int i, Unit& u) const {
        const long L = (long)i * G + c; if (L >= nwg) return false;
        int wgid = (int)L; { const int q = nwg / NXCD, r = nwg % NXCD, xcd = wgid % NXCD, off = wgid / NXCD; wgid = (xcd < r ? xcd * (q + 1) : r * (q + 1) + (xcd - r) * q) + off; }
        const int nig = wgm * nN, gid = wgid / nig, fm = gid * wgm, gsz = (nM - fm) < wgm ? (nM - fm) : wgm;
        u.pm = fm + ((wgid % nig) % gsz); u.pn = (wgid % nig) / gsz; return true;
    }
};

struct FixedOrder { int c; __host__ __device__ bool next(int i, Unit& u) const { if (i >= 16) return false; u.pm = 0; u.pn = i & 3; return true; } };
__device__ __forceinline__ unsigned cvt_pk_bf16(float lo, float hi) { unsigned r; asm volatile("v_cvt_pk_bf16_f32 %0, %1, %2" : "=v"(r) : "v"(lo), "v"(hi)); return r; }
__device__ __forceinline__ float bf_lo(unsigned w) { return __uint_as_float(w << 16); }
__device__ __forceinline__ float bf_hi(unsigned w) { return __uint_as_float(w & 0xffff0000u); }
__device__ __forceinline__ float fast_sigmoid(float z) { return __builtin_amdgcn_rcpf(1.0f + __builtin_amdgcn_exp2f(-1.4426950408889634f * z)); }
__device__ __forceinline__ float gelu_tanh(float y) { const float z = 0.7978845608028654f * (y + 0.044715f * y * y * y); return y * fast_sigmoid(2.0f * z); }

template <int ACT> struct EpiBf16 {
    static constexpr bool PERM = true, PERMA = false;
    bf16_t* O; int ldc; int split_tiles; size_t split_stride; int act_from; int tilemajor = 0;
    __device__ __forceinline__ void operator()(const f32x4 (&acc)[2][2][4][2], const Unit& u, int wr, int wc, int fr, int fq) const {
        int pn = u.pn; bf16_t* base = O;
        if (split_tiles) { const int t = pn / split_tiles; base += (size_t)t * split_stride; pn -= t * split_tiles; }
        if (tilemajor) { base += ((size_t)u.pm * (tilemajor - 1) + pn) * (size_t)(BM * BM); pn = 0; }
        const int col0 = pn * BM + wc * 32 + 8 * fq;
        const bool act1 = (ACT == 1) && (u.pn >= act_from);
        const unsigned e0 = ((unsigned)(wr * 64 + fr) * (unsigned)ldc + (unsigned)col0) * 2u;
        char* pb = (char*)(base + (size_t)u.pm * BM * ldc);
#pragma unroll
        for (int ai = 0; ai < 2; ++ai)
#pragma unroll
            for (int m = 0; m < 4; ++m) { bf16_t* rowp = (bf16_t*)(pb + (e0 + (unsigned)((ai * HALF + m * 16) * 2) * (unsigned)ldc));
#pragma unroll
                for (int bj = 0; bj < 2; ++bj) { f32x4 v0 = acc[ai][bj][m][0], v1 = acc[ai][bj][m][1];
                    if (ACT == 1) { if (act1) {
#pragma unroll
                        for (int j = 0; j < 4; ++j) { v0[j] = gelu_tanh(v0[j]); v1[j] = gelu_tanh(v1[j]); } } }
                    if (ACT == 2) {
#pragma unroll
                        for (int j = 0; j < 4; ++j) { const float a = fmaxf(v0[j], 0.f), b = fmaxf(v1[j], 0.f); v0[j] = a * a; v1[j] = b * b; } }
                    u32x4 w; w.x = cvt_pk_bf16(v0[0], v0[1]); w.y = cvt_pk_bf16(v0[2], v0[3]); w.z = cvt_pk_bf16(v1[0], v1[1]); w.w = cvt_pk_bf16(v1[2], v1[3]);
                    if (ACT == 2 || (ACT == 1 && act1)) __builtin_nontemporal_store(w, (PG8_GAS u32x4*)((PG8_GAS bf16_t*)rowp + bj * HALF));
                    else *(PG8_GAS u32x4*)((PG8_GAS bf16_t*)rowp + bj * HALF) = w; } }
    }
};
struct EpiHeadNorm {
    static constexpr bool PERM = true, PERMA = false;
    bf16_t* O; int ldc; int split_tiles; size_t split_stride; int hn_tiles; const float* hg; PG8_LAS float* xch;
    __device__ __forceinline__ void operator()(const f32x4 (&acc)[2][2][4][2], const Unit& u, int wr, int wc, int fr, int fq) const {
        int pn = u.pn; bf16_t* base = O;
        if (split_tiles) { const int t = pn / split_tiles; base += (size_t)t * split_stride; pn -= t * split_tiles; }
        const int col0 = pn * BM + wc * 32 + 8 * fq;
        const unsigned e0 = ((unsigned)(wr * 64 + fr) * (unsigned)ldc + (unsigned)col0) * 2u;
        char* pb = (char*)(base + (size_t)u.pm * BM * ldc);
        const bool hn = u.pn < hn_tiles;
        float rs[2][4][2];
        f32x4 g0 = {1.f, 1.f, 1.f, 1.f}, g1 = {1.f, 1.f, 1.f, 1.f};
        if (hn) {
            g0 = *(const PG8_GAS f32x4*)((const PG8_GAS float*)hg + wc * 32 + 8 * fq); g1 = *(const PG8_GAS f32x4*)((const PG8_GAS float*)hg + wc * 32 + 8 * fq + 4);
            const int l16 = ((fq * 16 + fr) ^ 16) << 2;
#pragma unroll
            for (int ai = 0; ai < 2; ++ai)
#pragma unroll
                for (int m = 0; m < 4; ++m)
#pragma unroll
                    for (int bj = 0; bj < 2; ++bj) { const f32x4 a = acc[ai][bj][m][0], b = acc[ai][bj][m][1];
                        float s = (a[0] * a[0] + a[1] * a[1]) + (a[2] * a[2] + a[3] * a[3]) + (b[0] * b[0] + b[1] * b[1]) + (b[2] * b[2] + b[3] * b[3]);
                        s += __int_as_float(__builtin_amdgcn_ds_bpermute(l16, __float_as_int(s)));
                        { auto rr = __builtin_amdgcn_permlane32_swap(__float_as_uint(s), __float_as_uint(s), false, false); s = __uint_as_float(rr[0]) + __uint_as_float(rr[1]); }
                        if (fq == 0) xch[((ai * HALF + wr * 64 + m * 16 + fr) * 2 + bj) * 4 + wc] = s; }
            asm volatile("s_waitcnt lgkmcnt(0)" ::: "memory"); __builtin_amdgcn_s_barrier(); asm volatile("" ::: "memory");
#pragma unroll
            for (int ai = 0; ai < 2; ++ai)
#pragma unroll
                for (int m = 0; m < 4; ++m)
#pragma unroll
                    for (int bj = 0; bj < 2; ++bj) { const f32x4 p = *(const PG8_LAS f32x4*)(xch + ((ai * HALF + wr * 64 + m * 16 + fr) * 2 + bj) * 4);
                        rs[ai][m][bj] = __builtin_amdgcn_rsqf(((p[0] + p[1]) + (p[2] + p[3])) * (1.0f / 128.0f) + NORM_EPS); }
        } else {
#pragma unroll
            for (int ai = 0; ai < 2; ++ai)
#pragma unroll
                for (int m = 0; m < 4; ++m) { rs[ai][m][0] = 1.f; rs[ai][m][1] = 1.f; }
        }
#pragma unroll
        for (int ai = 0; ai < 2; ++ai)
#pragma unroll
            for (int m = 0; m < 4; ++m) { bf16_t* rowp = (bf16_t*)(pb + (e0 + (unsigned)((ai * HALF + m * 16) * 2) * (unsigned)ldc));
#pragma unroll
                for (int bj = 0; bj < 2; ++bj) { const f32x4 v0 = acc[ai][bj][m][0] * rs[ai][m][bj] * g0, v1 = acc[ai][bj][m][1] * rs[ai][m][bj] * g1;
                    u32x4 w; w.x = cvt_pk_bf16(v0[0], v0[1]); w.y = cvt_pk_bf16(v0[2], v0[3]); w.z = cvt_pk_bf16(v1[0], v1[1]); w.w = cvt_pk_bf16(v1[2], v1[3]);
                    *(PG8_GAS u32x4*)((PG8_GAS bf16_t*)rowp + bj * HALF) = w; } }
    }
};
struct EpiDelta {
    static constexpr bool PERM = true, PERMA = false;
    bf16_t* O; const float* gate; int row0;
    __device__ __forceinline__ void operator()(const f32x4 (&acc)[2][2][4][2], const Unit& u, int wr, int wc, int fr, int fq) const {
        const int col0 = u.pn * BM + wc * 32 + 8 * fq; const int b = (row0 + u.pm * BM) / SEQ;
        f32x4 gv[2][2];
#pragma unroll
        for (int bj = 0; bj < 2; ++bj)
#pragma unroll
            for (int n = 0; n < 2; ++n) gv[bj][n] = *(const PG8_GAS f32x4*)((const PG8_GAS float*)gate + (size_t)b * NCOLS_MOD + col0 + bj * HALF + 4 * n);
        const unsigned e0 = ((unsigned)(wr * 64 + fr) * DM + (unsigned)col0) * 2u;
        PG8_GAS char* pb = (PG8_GAS char*)(O + (size_t)u.pm * BM * DM);
#pragma unroll
        for (int ai = 0; ai < 2; ++ai)
#pragma unroll
            for (int m = 0; m < 4; ++m)
#pragma unroll
                for (int bj = 0; bj < 2; ++bj) { const f32x4 v0 = acc[ai][bj][m][0] * gv[bj][0], v1 = acc[ai][bj][m][1] * gv[bj][1];
                    u32x4 w; w.x = cvt_pk_bf16(v0[0], v0[1]); w.y = cvt_pk_bf16(v0[2], v0[3]); w.z = cvt_pk_bf16(v1[0], v1[1]); w.w = cvt_pk_bf16(v1[2], v1[3]);
                    *(PG8_GAS u32x4*)(pb + e0 + (unsigned)(((ai * HALF + m * 16) * DM + bj * HALF) * 2)) = w; }
    }
};
struct EpiNull {
    static constexpr bool PERM = true, PERMA = false;
    __device__ __forceinline__ void operator()(const f32x4 (&acc)[2][2][4][2], const Unit& u, int wr, int wc, int fr, int fq) const {
#pragma unroll
        for (int ai = 0; ai < 2; ++ai)
#pragma unroll
            for (int bj = 0; bj < 2; ++bj)
#pragma unroll
                for (int m = 0; m < 4; ++m)
#pragma unroll
                    for (int n = 0; n < 2; ++n) asm volatile("" :: "v"(acc[ai][bj][m][n]));
    }
};
struct EpiDummy {
    static constexpr bool PERM = true, PERMA = false;
    unsigned char* dummy;
    __device__ __forceinline__ void operator()(const f32x4 (&acc)[2][2][4][2], const Unit& u, int wr, int wc, int fr, int fq) const {
        PG8_GAS char* base = (PG8_GAS char*)dummy + (size_t)((u.pm * 32 + u.pn) & 1023) * 131072 + (size_t)(wr * 4 + wc) * 16384 + (size_t)(fq * 16 + fr) * 16;
#pragma unroll
        for (int ai = 0; ai < 2; ++ai)
#pragma unroll
            for (int m = 0; m < 4; ++m)
#pragma unroll
                for (int bj = 0; bj < 2; ++bj) { f32x4 v0 = acc[ai][bj][m][0], v1 = acc[ai][bj][m][1];
#pragma unroll
                    for (int j = 0; j < 4; ++j) { const float a = fmaxf(v0[j], 0.f), b = fmaxf(v1[j], 0.f); v0[j] = a * a; v1[j] = b * b; }
                    u32x4 w; w.x = cvt_pk_bf16(v0[0], v0[1]); w.y = cvt_pk_bf16(v0[2], v0[3]); w.z = cvt_pk_bf16(v1[0], v1[1]); w.w = cvt_pk_bf16(v1[2], v1[3]);
                    *(PG8_GAS u32x4*)(base + ((ai * 4 + m) * 2 + bj) * 1024) = w; }
    }
};
struct EpiResid {
    static constexpr bool PERM = false, PERMA = false;
    const float* base; float* out; const float* gate; int row0; const bf16_t* dlt;
    __device__ __forceinline__ void operator()(const f32x4 (&acc)[2][2][4][2], const Unit& u, int wr, int wc, int fr, int fq) const {
        const int col0 = u.pn * BM + wc * 32 + 4 * fq; const int b = (row0 + u.pm * BM) / SEQ;
        f32x4 gv[2][2];
#pragma unroll
        for (int bj = 0; bj < 2; ++bj)
#pragma unroll
            for (int n = 0; n < 2; ++n) gv[bj][n] = *(const PG8_GAS f32x4*)((const PG8_GAS float*)gate + (size_t)b * NCOLS_MOD + col0 + bj * HALF + n * 16);
        const unsigned e0 = ((unsigned)(wr * 64 + fr) * DM + (unsigned)col0) * 4u;
        const char* bb = (const char*)(base + (size_t)u.pm * BM * DM); char* ob = (char*)(out + (size_t)u.pm * BM * DM); const char* db = (const char*)(dlt + (size_t)u.pm * BM * DM);
#pragma unroll
        for (int ai = 0; ai < 2; ++ai)
#pragma unroll
            for (int m = 0; m < 4; ++m) {
#pragma unroll
                for (int bj = 0; bj < 2; ++bj)
#pragma unroll
                    for (int n = 0; n < 2; ++n) { const unsigned e = e0 + (unsigned)(((ai * HALF + m * 16) * DM + bj * HALF + n * 16) * 4);
                        f32x4 bs = *(const PG8_GAS f32x4*)((const PG8_GAS char*)bb + e);
                        if (dlt) { const u32x2 dw = *(const PG8_GAS u32x2*)((const PG8_GAS char*)db + (e >> 1)); bs += (f32x4){bf_lo(dw.x), bf_hi(dw.x), bf_lo(dw.y), bf_hi(dw.y)}; }
                        *(PG8_GAS f32x4*)((PG8_GAS char*)ob + e) = bs + gv[bj][n] * acc[ai][bj][m][n]; }
                if (m & 1) asm volatile("" ::: "memory"); }
    }
};
template <int CTRL> __device__ __forceinline__ float dpp_old(float oldv, float v) { return __int_as_float(__builtin_amdgcn_update_dpp(__float_as_int(oldv), __float_as_int(v), CTRL, 0xf, 0xf, false)); }
struct EpiGate {
    static constexpr bool PERM = true, PERMA = true;
    const bf16_t* xc; const float* b_a; const float* b_i; const float* c8; bf16_t* HL; bf16_t* AC; float* Pc; float* Hc;
    __device__ __forceinline__ void operator()(const f32x4 (&acc)[2][2][4][2], const Unit& u, int wr, int wc, int fr, int fq) const {
        const int ch0 = (u.pn >> 1) * 256 + (u.pn & 1) * 128 + wc * 32 + 8 * fq;
        const unsigned e0 = (unsigned)(wr * 64 + 4 * fr) * DM + (unsigned)ch0;
        const PG8_GAS char* xcb = (const PG8_GAS char*)(xc + (size_t)u.pm * BM * DM); PG8_GAS char* hb = (PG8_GAS char*)(HL + (size_t)u.pm * BM * DM); PG8_GAS char* ab = (PG8_GAS char*)(AC + (size_t)u.pm * BM * DM);
        f32x4 ba[2], bi[2], cc[2];
#pragma unroll
        for (int n = 0; n < 2; ++n) { ba[n] = *(const PG8_GAS f32x4*)((const PG8_GAS float*)b_a + ch0 + 4 * n); bi[n] = *(const PG8_GAS f32x4*)((const PG8_GAS float*)b_i + ch0 + 4 * n); cc[n] = *(const PG8_GAS f32x4*)((const PG8_GAS float*)c8 + ch0 + 4 * n); }
#pragma unroll
        for (int ai = 0; ai < 2; ++ai) {
            float A[4][8], H[4][8];
#pragma unroll
            for (int m = 0; m < 4; ++m) { const unsigned e = e0 + (unsigned)((ai * HALF + m) * DM);
                const u32x4 xw = *(const PG8_GAS u32x4*)(xcb + e * 2u);
                const float xv[8] = {bf_lo(xw.x), bf_hi(xw.x), bf_lo(xw.y), bf_hi(xw.y), bf_lo(xw.z), bf_hi(xw.z), bf_lo(xw.w), bf_hi(xw.w)};
#pragma unroll
                for (int n = 0; n < 2; ++n)
#pragma unroll
                    for (int j = 0; j < 4; ++j) { const float r = fast_sigmoid(acc[ai][0][m][n][j] + ba[n][j]), ig = fast_sigmoid(acc[ai][1][m][n][j] + bi[n][j]);
                        const float a = __builtin_amdgcn_exp2f(1.4426950408889634f * cc[n][j] * r);
                        A[m][4 * n + j] = a; H[m][4 * n + j] = __builtin_amdgcn_sqrtf(fmaxf(1.0f - a * a, 0.f)) * (ig * xv[4 * n + j]); } }
#pragma unroll
            for (int c = 0; c < 8; ++c) {
#pragma unroll
                for (int m = 1; m < 4; ++m) { H[m][c] = fmaf(A[m][c], H[m - 1][c], H[m][c]); A[m][c] *= A[m - 1][c]; }
                float a = A[3][c], h = H[3][c];
                { const float ap = dpp_old<0x111>(1.0f, a), hp = dpp_old<0x111>(0.0f, h); h = fmaf(a, hp, h); a *= ap; }
                { const float ap = dpp_old<0x112>(1.0f, a), hp = dpp_old<0x112>(0.0f, h); h = fmaf(a, hp, h); a *= ap; }
                { const float ap = dpp_old<0x114>(1.0f, a), hp = dpp_old<0x114>(0.0f, h); h = fmaf(a, hp, h); a *= ap; }
                { const float ap = dpp_old<0x118>(1.0f, a), hp = dpp_old<0x118>(0.0f, h); h = fmaf(a, hp, h); a *= ap; }
                const float ap = dpp_old<0x111>(1.0f, a), hp = dpp_old<0x111>(0.0f, h);
#pragma unroll
                for (int m = 0; m < 4; ++m) { H[m][c] = fmaf(A[m][c], hp, H[m][c]); A[m][c] *= ap; }
            }
#pragma unroll
            for (int m = 0; m < 4; ++m) { const unsigned e = e0 + (unsigned)((ai * HALF + m) * DM);
                u32x4 wh, wa; wh.x = cvt_pk_bf16(H[m][0], H[m][1]); wh.y = cvt_pk_bf16(H[m][2], H[m][3]); wh.z = cvt_pk_bf16(H[m][4], H[m][5]); wh.w = cvt_pk_bf16(H[m][6], H[m][7]);
                wa.x = cvt_pk_bf16(A[m][0], A[m][1]); wa.y = cvt_pk_bf16(A[m][2], A[m][3]); wa.z = cvt_pk_bf16(A[m][4], A[m][5]); wa.w = cvt_pk_bf16(A[m][6], A[m][7]);
                *(PG8_GAS u32x4*)(hb + e * 2u) = wh; *(PG8_GAS u32x4*)(ab + e * 2u) = wa; }
            if (fr == 15) { const size_t o = (size_t)(u.pm * 4 + ai * 2 + wr) * DM + ch0;
                *(PG8_GAS f32x4*)((PG8_GAS float*)Pc + o) = (f32x4){A[3][0], A[3][1], A[3][2], A[3][3]}; *(PG8_GAS f32x4*)((PG8_GAS float*)Pc + o + 4) = (f32x4){A[3][4], A[3][5], A[3][6], A[3][7]};
                *(PG8_GAS f32x4*)((PG8_GAS float*)Hc + o) = (f32x4){H[3][0], H[3][1], H[3][2], H[3][3]}; *(PG8_GAS f32x4*)((PG8_GAS float*)Hc + o + 4) = (f32x4){H[3][4], H[3][5], H[3][6], H[3][7]}; }
            asm volatile("" ::: "memory");
        }
    }
};

template <class Epi, class Sched, int A_AUX = 0>
__device__ __forceinline__ void gemm_phase(PG8_LAS unsigned char* lds, const Gemm g, const Sched& S, const Epi& E, const int tid  ) {
    const int wid = __builtin_amdgcn_readfirstlane(tid >> 6), lane = tid & 63, wr = wid >> 2, wc = wid & 3, fr = lane & 15, fq = lane >> 4;
    const int K = g.K, nt = K / BK, lda = g.lda, ldb = g.ldb;
    unsigned voffA[2], voffB[2];
#pragma unroll
    for (int i = 0; i < 2; ++i) { int R, C; stage_rc(tid * 16 + i * 8192, R, C); const int Rb = Epi::PERM ? ((R & ~31) + perm32(R & 31)) : R;
        const int Ra = Epi::PERMA ? ((R & 64) + 4 * (R & 15) + ((R >> 4) & 3)) : R;
        voffA[i] = (unsigned)(Ra * lda + C) * 2u; voffB[i] = (unsigned)(Rb * ldb + C) * 2u; }
    const size_t kstep = (size_t)(BK * 2);
    const size_t hstepA = (size_t)HALF * lda * 2, hstepB = (size_t)HALF * ldb * 2;
    const size_t tstepA = 2 * hstepA, tstepB = 2 * hstepB;
    const unsigned ldsw = (unsigned)wid * 1024u;
    const int aoff = lds_byte(wr * 64 + fr, fq * 8), boff = lds_byte(wc * 32 + fr, fq * 8);
#define PG8_SA(b, h) (((b) * 2 + (h)) * HTB)
#define PG8_SB(b, h) ((4 + (b) * 2 + (h)) * HTB)
#define PG8_STAGE_X(bufoff, gbase, voff, aux) do { _Pragma("unroll") for (int _i = 0; _i < 2; ++_i) \
        __builtin_amdgcn_global_load_lds((const PG8_GAS unsigned*)((const PG8_GAS char*)(gbase) + (voff)[_i]), (PG8_LAS unsigned*)(lds + (bufoff) + ldsw + _i * 8192), 16, 0, aux); } while (0)
#define PG8_STAGE(bufoff, gbase, voff) do { if (&(voff)[0] == &voffA[0]) { PG8_STAGE_X(bufoff, gbase, voff, A_AUX); } else { PG8_STAGE_X(bufoff, gbase, voff, 0); } } while (0)
#define PG8_LDA(dst, b, h) do { _Pragma("unroll") for (int m = 0; m < 4; ++m) _Pragma("unroll") for (int k = 0; k < 2; ++k) dst[m][k] = *(const PG8_LAS bf16x8*)(lds + PG8_SA(b, h) + aoff + m * 2048 + k * 1024); } while (0)
#define PG8_LDB(dst, b, h) do { _Pragma("unroll") for (int n = 0; n < 2; ++n) _Pragma("unroll") for (int k = 0; k < 2; ++k) dst[n][k] = *(const PG8_LAS bf16x8*)(lds + PG8_SB(b, h) + boff + n * 2048 + k * 1024); } while (0)
#define PG8_MMA(ai, bj, At, Bt) do { __builtin_amdgcn_s_setprio(1); _Pragma("unroll") for (int m = 0; m < 4; ++m) _Pragma("unroll") for (int n = 0; n < 2; ++n) _Pragma("unroll") for (int k = 0; k < 2; ++k) \
        acc[ai][bj][m][n] = __builtin_amdgcn_mfma_f32_16x16x32_bf16(Bt[n][k], At[m][k], acc[ai][bj][m][n], 0, 0, 0); __builtin_amdgcn_s_setprio(0); } while (0)
#define PG8_WAIT_V(n) asm volatile("s_waitcnt vmcnt(" #n ")" ::: "memory")
#define PG8_WAIT_L(n) asm volatile("s_waitcnt lgkmcnt(" #n ")" ::: "memory")
#define PG8_BAR __builtin_amdgcn_s_barrier()
#define PG8_SCHED __builtin_amdgcn_sched_barrier(0)
#define PG8_ABASE(u_) ((const char*)g.A + (size_t)(u_).pm * (g.atile ? (size_t)BM * K * 2 : tstepA) + (g.adiv ? (size_t)((u_).pn / g.adiv) * (size_t)K * 2 : (size_t)0))
#define PG8_KOFF(t_) (g.atile ? ((size_t)((t_) >> 2) * 131072u + (size_t)((t_) & 3) * 128u) : (size_t)(t_) * kstep)
#define PG8_BBASE(u_) ((const char*)g.Bt + (size_t)(u_).pn * tstepB)
    Unit cur, nxt; int ui = 0;
    if (!S.next(0, cur)) return;
    f32x4 acc[2][2][4][2];
#pragma unroll
    for (int a = 0; a < 2; ++a)
#pragma unroll
        for (int b = 0; b < 2; ++b)
#pragma unroll
            for (int m = 0; m < 4; ++m)
#pragma unroll
                for (int n = 0; n < 2; ++n) acc[a][b][m][n] = (f32x4){0.f, 0.f, 0.f, 0.f};
    bf16x8 At[4][2], B0[2][2], B1[2][2];
    const char* cA = PG8_ABASE(cur); const char* cB = PG8_BBASE(cur);
    PG8_STAGE(PG8_SB(0, 0), cB, voffB); PG8_STAGE(PG8_SB(0, 1), cB + hstepB, voffB); PG8_STAGE(PG8_SA(0, 0), cA, voffA); PG8_STAGE(PG8_SA(0, 1), cA + hstepA, voffA);
    if (wr == 1) PG8_BAR;
    PG8_WAIT_V(2); PG8_BAR;
    PG8_STAGE(PG8_SB(1, 0), cB + kstep, voffB); PG8_STAGE(PG8_SA(1, 0), cA + kstep, voffA); PG8_STAGE(PG8_SB(1, 1), cB + hstepB + kstep, voffB);
    PG8_WAIT_V(6); PG8_BAR;
    for (;;) {
        const bool has_next = S.next(ui + 1, nxt);
        const char* nA = has_next ? PG8_ABASE(nxt) : cA; const char* nB = has_next ? PG8_BBASE(nxt) : cB;
#pragma clang loop unroll(disable)
        for (int t = 0; t < nt; t += 2) {
            const bool last = (t == nt - 2);
            const char* a1 = cA + PG8_KOFF(t + 1);
            const char* a2 = last ? nA : cA + PG8_KOFF(t + 2); const char* b2 = last ? nB : cB + (size_t)(t + 2) * kstep;
            const char* a3 = a2 + kstep; const char* b3 = b2 + kstep;
            PG8_LDB(B0, 0, 0); PG8_LDB(B1, 0, 1); PG8_SCHED; PG8_LDA(At, 0, 0); PG8_STAGE(PG8_SA(1, 1), a1 + hstepA, voffA);
            PG8_WAIT_V(8); PG8_WAIT_L(0); PG8_BAR; PG8_MMA(0, 0, At, B0); PG8_MMA(0, 1, At, B1); PG8_BAR; PG8_SCHED;
            PG8_LDA(At, 0, 1); PG8_STAGE(PG8_SB(0, 0), b2, voffB); PG8_STAGE(PG8_SB(0, 1), b2 + hstepB, voffB); PG8_STAGE(PG8_SA(0, 0), a2, voffA);
            PG8_WAIT_V(8); PG8_WAIT_L(0); PG8_BAR; PG8_MMA(1, 0, At, B0); PG8_MMA(1, 1, At, B1); PG8_BAR; PG8_SCHED;
            PG8_LDB(B0, 1, 0); PG8_LDB(B1, 1, 1); PG8_SCHED; PG8_LDA(At, 1, 0); PG8_STAGE(PG8_SA(0, 1), a2 + hstepA, voffA);
            PG8_WAIT_V(8); PG8_WAIT_L(0); PG8_BAR; PG8_MMA(0, 0, At, B0); PG8_MMA(0, 1, At, B1); PG8_BAR; PG8_SCHED;
            PG8_LDA(At, 1, 1); PG8_STAGE(PG8_SB(1, 0), b3, voffB); PG8_STAGE(PG8_SB(1, 1), b3 + hstepB, voffB); PG8_STAGE(PG8_SA(1, 0), a3, voffA);
            PG8_WAIT_V(8); PG8_WAIT_L(0); PG8_BAR; PG8_MMA(1, 0, At, B0); PG8_MMA(1, 1, At, B1); PG8_BAR; PG8_SCHED;
        }
        if (wr == 0) PG8_BAR;
        E(acc, cur, wr, wc, fr, fq);
        if (!has_next) break;
#pragma unroll
        for (int a = 0; a < 2; ++a)
#pragma unroll
            for (int b = 0; b < 2; ++b)
#pragma unroll
                for (int m = 0; m < 4; ++m)
#pragma unroll
                    for (int n = 0; n < 2; ++n) acc[a][b][m][n] = (f32x4){0.f, 0.f, 0.f, 0.f};
        cur = nxt; cA = nA; cB = nB; ++ui;
        if (wr == 1) PG8_BAR;
    }
    PG8_WAIT_V(0);
    PG8_BAR;
#undef PG8_SA
#undef PG8_SB
#undef PG8_STAGE
#undef PG8_STAGE_X
#undef PG8_LDA
#undef PG8_LDB
#undef PG8_MMA
#undef PG8_WAIT_V
#undef PG8_WAIT_L
#undef PG8_BAR
#undef PG8_SCHED
#undef PG8_ABASE
#undef PG8_KOFF
#undef PG8_BBASE
}
}

namespace fox {
#define FOX_GAS __attribute__((address_space(1)))
using bf16 = __hip_bfloat16;
typedef short bf16x8 __attribute__((ext_vector_type(8)));
typedef short s16x4 __attribute__((ext_vector_type(4)));
typedef float f32x16 __attribute__((ext_vector_type(16)));
typedef float f32x4 __attribute__((ext_vector_type(4)));
typedef unsigned u32x4 __attribute__((ext_vector_type(4)));
constexpr int D = 128, RS = 2048;
constexpr float SCALE = 0.08838834764831845f, INV_SCALE = 11.313708498984761f;
constexpr float THR = 8.f;
constexpr int NW = 8, QBLK = 32, KVBLK = 64, QB = NW * QBLK;
constexpr int SHM_V = KVBLK * D * 2, SHM_K = KVBLK * D * 2;
constexpr int OFF_WS = 2 * SHM_V + 2 * SHM_K, OFF_F = OFF_WS + NW * 64 * 4;
constexpr int LDS_BYTES_ATT = OFF_F + 2 * 64 * 4;
constexpr unsigned WBIG = 0x40000000u;

#define KSWZ(row, colB) ((row) * 256 + ((colB) ^ (((row) & 7) << 4)))
#define SBAR() __builtin_amdgcn_sched_barrier(0)
__device__ __forceinline__ int v_st(int k, int c) { const int kk = (k & ~0xC) | ((k & 4) << 1) | ((k & 8) >> 1); return ((kk >> 3) * 4 + (c >> 5)) * 512 + ((kk & 7) * 32 + (c & 31)) * 2; }
__device__ __forceinline__ int v_rd_base(int lane) { return ((lane & 3) << 3) | (((lane >> 2) & 3) << 6) | (((lane >> 4) & 1) << 5) | (((lane >> 5) & 1) << 8); }
constexpr int v_rd_off(int d0, int ks, int half) { return d0 * 512 + ks * 4096 + half * 2048; }
__device__ __forceinline__ int crow(int r, int hi) { return (r & 3) + 8 * (r >> 2) + 4 * hi; }
__device__ __forceinline__ unsigned cvtpk(float lo, float hi) { unsigned r; asm volatile("v_cvt_pk_bf16_f32 %0, %1, %2" : "=v"(r) : "v"(lo), "v"(hi)); return r; }
__device__ __forceinline__ bf16x8 load8(const bf16* p) { return *reinterpret_cast<const bf16x8*>(p); }
__device__ __forceinline__ void mask_tile(f32x16& p0, f32x16& p1, int dq) {
    const float NEG = -__builtin_inff();
#pragma unroll
    for (int r = 0; r < 16; ++r) {
        const int c = (r & 3) + 8 * (r >> 2);
        if ((unsigned)(dq - c) >= WBIG) p0[r] = NEG;
        if ((unsigned)(dq - c - 32) >= WBIG) p1[r] = NEG;
    }
}
__device__ __forceinline__ bool partialSM(f32x16& p0, f32x16& p1, float& m_reg, float& mn, float& alpha) {
    float pmax = p0[0]; for (int r = 1; r < 16; ++r) pmax = fmaxf(pmax, p0[r]); for (int r = 0; r < 16; ++r) pmax = fmaxf(pmax, p1[r]);
    { auto rr = __builtin_amdgcn_permlane32_swap(__float_as_uint(pmax), __float_as_uint(pmax), false, false);
      pmax = fmaxf(__uint_as_float(rr[0]), __uint_as_float(rr[1])); }
    constexpr float C2 = 1.4426950408889634f * SCALE;
    if (__all((pmax - m_reg) * SCALE < -30.0f)) { mn = m_reg; alpha = 1.f; return true; }
    if (__builtin_expect(__all((pmax - m_reg) * SCALE <= THR), 1)) { mn = m_reg; alpha = 1.f; }
    else { mn = fmaxf(m_reg, pmax); alpha = __builtin_amdgcn_exp2f((m_reg - mn) * C2); m_reg = mn; }
    const float mnL = -mn * C2;
    for (int r = 0; r < 16; ++r) p0[r] = fmaf(p0[r], C2, mnL); for (int r = 0; r < 16; ++r) p1[r] = fmaf(p1[r], C2, mnL);
    for (int r = 0; r < 16; ++r) p0[r] = __builtin_amdgcn_exp2f(p0[r]);
    return false;
}
__device__ __forceinline__ void finishSM(f32x16& p0, f32x16& p1, float alpha, float& l_reg, bf16x8& pa0, bf16x8& pa1, bf16x8& pa2, bf16x8& pa3) {
    for (int r = 0; r < 16; ++r) p1[r] = __builtin_amdgcn_exp2f(p1[r]);
    float ps = 0; for (int r = 0; r < 16; ++r) ps += p0[r]; for (int r = 0; r < 16; ++r) ps += p1[r];
    { auto rr = __builtin_amdgcn_permlane32_swap(__float_as_uint(ps), __float_as_uint(ps), false, false);
      ps = __uint_as_float(rr[0]) + __uint_as_float(rr[1]); }
    l_reg = l_reg * alpha + ps;
#define PK4(P, B_, OUT) do { unsigned a0 = cvtpk(P[B_+0], P[B_+1]), a1 = cvtpk(P[B_+2], P[B_+3]);                          \
        unsigned b0 = cvtpk(P[B_+4], P[B_+5]), b1 = cvtpk(P[B_+6], P[B_+7]);                                             \
        auto r0 = __builtin_amdgcn_permlane32_swap(a0, b0, false, false); auto r1 = __builtin_amdgcn_permlane32_swap(a1, b1, false, false); \
        u32x4 w = {r0[0], r1[0], r0[1], r1[1]}; OUT = *reinterpret_cast<bf16x8*>(&w); } while (0)
    PK4(p0, 0, pa0); PK4(p0, 8, pa1); PK4(p1, 0, pa2); PK4(p1, 8, pa3);
#undef PK4
}
template <int KB>
__device__ __forceinline__ void qkt(f32x16& p0, f32x16& p1, const char* K_lds, int r32, int hi, const bf16x8* qr) {
    { const float* fb = (const float*)(K_lds + 2 * SHM_K + NW * 256 + KB * 256) + 4 * hi;
      const f32x4 a0 = *(const f32x4*)(fb), a1 = *(const f32x4*)(fb + 8), a2 = *(const f32x4*)(fb + 16), a3 = *(const f32x4*)(fb + 24);
      const f32x4 b0 = *(const f32x4*)(fb + 32), b1 = *(const f32x4*)(fb + 40), b2 = *(const f32x4*)(fb + 48), b3 = *(const f32x4*)(fb + 56);
      p0 = (f32x16){a0[0], a0[1], a0[2], a0[3], a1[0], a1[1], a1[2], a1[3], a2[0], a2[1], a2[2], a2[3], a3[0], a3[1], a3[2], a3[3]};
      p1 = (f32x16){b0[0], b0[1], b0[2], b0[3], b1[0], b1[1], b1[2], b1[3], b2[0], b2[1], b2[2], b2[3], b3[0], b3[1], b3[2], b3[3]}; }
    const char* kb[4];
#pragma unroll
    for (int dd = 0; dd < 4; ++dd) kb[dd] = K_lds + KB * SHM_K + KSWZ(r32, (dd * 16 + hi * 8) * 2);
#pragma unroll
    for (int d0 = 0; d0 < 8; ++d0) { const char* a = kb[d0 & 3] + (d0 >> 2) * 128;
        bf16x8 b0 = *reinterpret_cast<const bf16x8*>(a);
        bf16x8 b1 = *reinterpret_cast<const bf16x8*>(a + 32 * 256);
        p0 = __builtin_amdgcn_mfma_f32_32x32x16_bf16(b0, qr[d0], p0, 0, 0, 0);
        p1 = __builtin_amdgcn_mfma_f32_32x32x16_bf16(b1, qr[d0], p1, 0, 0, 0); }
}
template <int VB>
__device__ __forceinline__ void pv_tile(f32x16* o, int vb0, bf16x8 pa0, bf16x8 pa1, bf16x8 pa2, bf16x8 pa3) {
#define TRRD(dst, off) asm volatile("ds_read_b64_tr_b16 %0, %1 offset:%2" : "=&v"(dst) : "v"(vb0), "i"(off) : "memory")
#define PV_D0(d0) do { s16x4 l0, l1, l2, l3, h0, h1, h2, h3; constexpr int b_ = VB * SHM_V + v_rd_off(d0, 0, 0);  \
        TRRD(l0, b_); TRRD(h0, b_ + 2048); TRRD(l1, b_ + 4096); TRRD(h1, b_ + 6144); TRRD(l2, b_ + 8192); TRRD(h2, b_ + 10240); TRRD(l3, b_ + 12288); TRRD(h3, b_ + 14336); \
        asm volatile("s_waitcnt lgkmcnt(0)" ::: "memory"); SBAR();   \
        o[d0] = __builtin_amdgcn_mfma_f32_32x32x16_bf16(pa0, (bf16x8){l0[0], l0[1], l0[2], l0[3], h0[0], h0[1], h0[2], h0[3]}, o[d0], 0, 0, 0);   \
        o[d0] = __builtin_amdgcn_mfma_f32_32x32x16_bf16(pa1, (bf16x8){l1[0], l1[1], l1[2], l1[3], h1[0], h1[1], h1[2], h1[3]}, o[d0], 0, 0, 0);   \
        o[d0] = __builtin_amdgcn_mfma_f32_32x32x16_bf16(pa2, (bf16x8){l2[0], l2[1], l2[2], l2[3], h2[0], h2[1], h2[2], h2[3]}, o[d0], 0, 0, 0);   \
        o[d0] = __builtin_amdgcn_mfma_f32_32x32x16_bf16(pa3, (bf16x8){l3[0], l3[1], l3[2], l3[3], h3[0], h3[1], h3[2], h3[3]}, o[d0], 0, 0, 0); } while (0)
    PV_D0(0); PV_D0(1); PV_D0(2); PV_D0(3);
#undef PV_D0
#undef TRRD
}

struct BlockRef { unsigned q, k, v, f, o; int P0, jlo; float fref; };
typedef __amdgpu_buffer_rsrc_t rsrc_t;
typedef unsigned u32x4v __attribute__((ext_vector_type(4)));
struct Seam { bf16x8 qr[8]; bf16x8 st_v0, st_v1, st_k0, st_k1; float st_f; };
__device__ __forceinline__ bf16x8 bld8(rsrc_t rs, unsigned voff, unsigned soff) { return __builtin_bit_cast(bf16x8, __builtin_amdgcn_raw_buffer_load_b128(rs, (int)voff, (int)soff, 0)); }
__device__ __forceinline__ float bldf(rsrc_t rs, unsigned voff, unsigned soff) { return __uint_as_float(__builtin_amdgcn_raw_buffer_load_b32(rs, (int)voff, (int)soff, 0)); }
#define ROWS(base, k0, rr) ((base) + (unsigned)(((k0) + (rr)) * RS * 2))
#define VMW() asm volatile("s_waitcnt vmcnt(0)" ::: "memory")
#define VMWN(n) asm volatile("s_waitcnt vmcnt(%0)" :: "i"(n) : "memory")
#define SLOAD_H(Kp, Vp, Fp, k0) do { S.st_v0 = bld8(rs, toff, ROWS(Vp, k0, 0)); S.st_v1 = bld8(rs, toff, ROWS(Vp, k0, 32));              \
                         S.st_k0 = bld8(rs, toff, ROWS(Kp, k0, 0)); S.st_k1 = bld8(rs, toff, ROWS(Kp, k0, 32)); S.st_f = bldf(rs, foff, (Fp) + (unsigned)((k0) * 4)); } while (0)
#define SWRITE_HK(bf, fref_) do { *(bf16x8*)(K_lds + (bf) * SHM_K + kws) = S.st_k0; *(bf16x8*)(K_lds + (bf) * SHM_K + kws + 32 * 256) = S.st_k1; \
                         if (wid == 0) F_lds[(bf) * 64 + lane] = ((fref_) - S.st_f) * INV_SCALE; } while (0)
#define SWRITE_HV(bf) do { *(bf16x8*)(V_lds + (bf) * SHM_V + vst0) = S.st_v0; *(bf16x8*)(V_lds + (bf) * SHM_V + vst1) = S.st_v1; } while (0)
__device__ __forceinline__ void fox_prime(const BlockRef& cur, char* lds, Seam& S, const int tid, const rsrc_t rs) {
    const int wid = __builtin_amdgcn_readfirstlane(tid >> 6), lane = tid & 63, r32 = lane & 31, hi = lane >> 5;
    const int sr = tid >> 4, sc = (tid & 15) * 8, kws = KSWZ(sr, sc * 2); char* K_lds = lds + 2 * SHM_V; float* F_lds = (float*)(lds + OFF_F);
    const unsigned toff = (unsigned)(sr * RS + sc) * 2u, foff = (unsigned)(tid & 63) * 4u, qoff = (unsigned)(r32 * RS + hi * 8) * 2u;
    { const unsigned qs = cur.q + (unsigned)(wid * QBLK * RS * 2);
#pragma unroll
      for (int d0 = 0; d0 < 8; ++d0) S.qr[d0] = bld8(rs, qoff + d0 * 32, qs); }
    SLOAD_H(cur.k, cur.v, cur.f, cur.P0 + QB - KVBLK); VMW(); SWRITE_HK(0, cur.fref);
    __syncthreads();
}
__device__ __forceinline__ void fox_block(const BlockRef& cur, const BlockRef& nxt, char* lds, Seam& S, const int tid, const rsrc_t rs, unsigned* qctr, const bool pull, int* mbox, const float cdyn) {
    const int wid = __builtin_amdgcn_readfirstlane(tid >> 6), lane = tid & 63, r32 = lane & 31, hi = lane >> 5;
    const int NT = (cur.P0 + QB) / KVBLK; int NTT = NT - cur.jlo;
    const int qlo = cur.P0 + wid * QBLK, qm = qlo + r32 - 4 * hi;
    char* V_lds = lds; char* K_lds = lds + 2 * SHM_V; float* F_lds = (float*)(lds + OFF_F);
    float* ws = (float*)(lds + OFF_WS) + wid * 64; float* li_l = ws, * al_l = ws + 32;
    float m_reg = -1e30f, l_reg = 0; f32x16 o[4] = {};
    const int sr = tid >> 4, sc = (tid & 15) * 8, vst0 = v_st(sr, sc), vst1 = v_st(32 + sr, sc), kws = KSWZ(sr, sc * 2);
    const unsigned toff = (unsigned)(sr * RS + sc) * 2u, foff = (unsigned)(tid & 63) * 4u, qoff = (unsigned)(r32 * RS + hi * 8) * 2u;
    const int vb0 = (int)(uintptr_t)V_lds + v_rd_base(lane);
    const unsigned Kh = cur.k, Vh = cur.v, Fh = cur.f; const float fref = cur.fref;
#define RESC(a) do { if (__any((a) < 1.f)) { if (hi == 0) al_l[r32] = (a); asm volatile("s_waitcnt lgkmcnt(0)" ::: "memory");              \
                     for (int d_ = 0; d_ < 4; ++d_) for (int r = 0; r < 16; ++r) o[d_][r] *= al_l[crow(r, hi)]; } } while (0)
#define KBASE(t) ((NT - 1 - (t)) * KVBLK)
#define MASKT(P0_, P1_, t) do { const int kb_ = KBASE(t); if (kb_ + KVBLK - 1 > qlo) mask_tile(P0_, P1_, qm - kb_); } while (0)
    constexpr int NQL = 8;
#define SEAM_K0() do { VMWN(NQL); SWRITE_HK(0, nxt.fref); SBAR(); } while (0)
    f32x16 pA0, pA1, pB0, pB1; float mnA, mnB, alA, alB; bf16x8 pa0, pa1, pa2, pa3;
    unsigned pulled = 0x7fffffffu;
    if (pull && tid == 0) pulled = __hip_atomic_fetch_add(qctr, 1u, __ATOMIC_RELAXED, __HIP_MEMORY_SCOPE_AGENT);
    SWRITE_HV(0); SBAR();
    SLOAD_H(Kh, Vh, Fh, KBASE(1));
    SBAR(); qkt<0>(pA0, pA1, K_lds, r32, hi, S.qr);
    bool dA = false, dB = false;
    MASKT(pA0, pA1, 0); dA = partialSM(pA0, pA1, m_reg, mnA, alA);
    VMW(); SWRITE_HV(1); SWRITE_HK(1, fref);
    if (tid == 0) *mbox = (int)pulled;
    __syncthreads();
#define HALF_STEP(PX0, PX1, mnX, alX, dX, PY0, PY1, alY, dY, t, KB, VB, SB) do {                                              \
        SBAR(); qkt<KB>(PX0, PX1, K_lds, r32, hi, S.qr);                                                                      \
        if (!(dY)) { finishSM(PY0, PY1, alY, l_reg, pa0, pa1, pa2, pa3); } SBAR();                                            \
        if ((t) + 1 < NTT) { SLOAD_H(Kh, Vh, Fh, KBASE((t) + 1)); SBAR(); }                                                   \
        if (!(dY)) { pv_tile<VB>(o, vb0, pa0, pa1, pa2, pa3); } MASKT(PX0, PX1, (t)); dX = partialSM(PX0, PX1, m_reg, mnX, alX); \
        __syncthreads();                                                                                                      \
        if ((t) + 1 < NTT) { VMW(); SWRITE_HV(SB); SWRITE_HK(SB, fref); }                                                     \
        RESC(alX); __syncthreads(); } while (0)
    float mthr = -3.0e38f; float* mins = (float*)(lds + LDS_BYTES_ATT + 16);
    for (int t = 1; t + 1 < NTT; t += 2) {
        HALF_STEP(pB0, pB1, mnB, alB, dB, pA0, pA1, alA, dA, t, 1, 0, 0);
        if (t == 3) { float wm = m_reg;
            wm = fminf(wm, __int_as_float(__builtin_amdgcn_update_dpp(0, __float_as_int(wm), 0xB1, 0xf, 0xf, true))); wm = fminf(wm, __int_as_float(__builtin_amdgcn_update_dpp(0, __float_as_int(wm), 0x4E, 0xf, 0xf, true)));
            wm = fminf(wm, __int_as_float(__builtin_amdgcn_update_dpp(0, __float_as_int(wm), 0x124, 0xf, 0xf, true))); wm = fminf(wm, __int_as_float(__builtin_amdgcn_update_dpp(0, __float_as_int(wm), 0x128, 0xf, 0xf, true)));
            wm = fminf(wm, __int_as_float(__builtin_amdgcn_ds_bpermute((lane ^ 16) << 2, __float_as_int(wm))));
            if (lane == 0) mins[wid] = wm; }
        HALF_STEP(pA0, pA1, mnA, alA, dA, pB0, pB1, alB, dB, t + 1, 0, 1, 1);
        if (t >= 3) {
            if (t == 3) { float mm = mins[0];
#pragma unroll
                for (int w = 1; w < NW; ++w) mm = fminf(mm, mins[w]);
                mthr = __uint_as_float(__builtin_amdgcn_readfirstlane(__float_as_uint(mm))) - cdyn; }
            const float bfirst = __uint_as_float(__builtin_amdgcn_readfirstlane(__float_as_uint(F_lds[64])));
            if (bfirst < mthr && t + 3 < NTT) NTT = t + 3;
        }
    }
    SBAR(); qkt<1>(pB0, pB1, K_lds, r32, hi, S.qr); SBAR();
    SLOAD_H(nxt.k, nxt.v, nxt.f, nxt.P0 + QB - KVBLK); SBAR();
    { const unsigned qs = nxt.q + (unsigned)(wid * QBLK * RS * 2);
#pragma unroll
      for (int d0 = 0; d0 < 8; ++d0) S.qr[d0] = bld8(rs, qoff + d0 * 32, qs); }
    SBAR();
    if (!dA) { finishSM(pA0, pA1, alA, l_reg, pa0, pa1, pa2, pa3); SBAR();
        pv_tile<0>(o, vb0, pa0, pa1, pa2, pa3); }
    MASKT(pB0, pB1, NTT - 1); dB = partialSM(pB0, pB1, m_reg, mnB, alB); __syncthreads(); RESC(alB);
    if (!dB) { finishSM(pB0, pB1, alB, l_reg, pa0, pa1, pa2, pa3); SBAR(); pv_tile<1>(o, vb0, pa0, pa1, pa2, pa3); }
    SBAR(); SEAM_K0();
    if (hi == 0) li_l[r32] = l_reg; asm volatile("s_waitcnt lgkmcnt(0)" ::: "memory");
    float rli[16];
#pragma unroll
    for (int r = 0; r < 16; ++r) rli[r] = __builtin_amdgcn_rcpf(li_l[crow(r, hi)]);
    const unsigned ooff = (unsigned)(4 * hi * RS + r32) * 2u;
#pragma unroll
    for (int r = 0; r < 16; ++r) { const unsigned os = cur.o + (unsigned)((wid * QBLK + (r & 3) + 8 * (r >> 2)) * RS * 2);
#pragma unroll
        for (int d0 = 0; d0 < 4; ++d0) { const float v = o[d0][r] * rli[r];
            const float vn = __int_as_float(__builtin_amdgcn_update_dpp(0, __float_as_int(v), 0xB1, 0xf, 0xf, true));
            if ((r32 & 1) == 0) __builtin_amdgcn_raw_buffer_store_b32(cvtpk(v, vn), rs, (int)(ooff + d0 * 64), (int)os, 0); } }
    __syncthreads();
#undef RESC
#undef KBASE
#undef MASKT
#undef SEAM_K0
#undef HALF_STEP
}
#undef ROWS
#undef VMW
#undef VMWN
#undef SLOAD_H
#undef SWRITE_HK
#undef SWRITE_HV
#undef KSWZ
#undef SBAR
}

struct Frame {
    LAS unsigned char* lds;
    int tid, lane, wave, vcu, G, gw, NGW, bid;
};
__device__ __forceinline__ Frame relaunder(const Frame& F0) {
    Frame F; F.lds = F0.lds; int w = F0.wave, bx = F0.bid, G = F0.G;
    unsigned ones = ~0u; asm volatile("" : "+s"(ones));
    int ln = (int)__builtin_amdgcn_mbcnt_hi(ones, __builtin_amdgcn_mbcnt_lo(ones, 0u)); asm volatile("" : "+s"(w)); asm volatile("" : "+s"(bx)); asm volatile("" : "+s"(G));
    F.tid = w * 64 + ln; F.lane = ln; F.wave = w; F.bid = bx; F.G = G;
    F.vcu = (G % 8 == 0) ? (bx % 8) * (G / 8) + bx / 8 : bx; F.gw = F.vcu * NWAVES + F.wave; F.NGW = G * NWAVES; return F; }
template <int CTRL> __device__ __forceinline__ float dppf(float v) { return __int_as_float(__builtin_amdgcn_update_dpp(0, __float_as_int(v), CTRL, 0xf, 0xf, true)); }
__device__ __forceinline__ float xor1(float v) { return dppf<0xB1>(v); }
__device__ __forceinline__ float xor2(float v) { return dppf<0x4E>(v); }
__device__ __forceinline__ float bperm(float v, int srclane) { return __int_as_float(__builtin_amdgcn_ds_bpermute(srclane << 2, __float_as_int(v))); }
__device__ __forceinline__ float wave_sum(float v, int lane) {
    v += xor1(v); v += xor2(v); v += dppf<0x124>(v); v += dppf<0x128>(v);
    v += bperm(v, lane ^ 16);
    { auto rr = __builtin_amdgcn_permlane32_swap(__float_as_uint(v), __float_as_uint(v), false, false); v = __uint_as_float(rr[0]) + __uint_as_float(rr[1]); }
    return v;
}
__device__ __forceinline__ float bflo(unsigned w) { return __uint_as_float(w << 16); }
__device__ __forceinline__ float bfhi(unsigned w) { return __uint_as_float(w & 0xffff0000u); }

__device__ __forceinline__ void transpose_item(const float* W, int ldw, bf16* WT, int ldt, int k0, int n0, int drow0, LAS float* scr, int lane) {
    float t[32];
    const GAS float* wp = (const GAS float*)W + (size_t)(k0 + (lane >> 5)) * ldw + n0 + (lane & 31);
#pragma unroll
    for (int i = 0; i < 32; ++i) t[i] = wp[(size_t)(2 * i) * ldw];
#pragma unroll
    for (int i = 0; i < 32; ++i) scr[(2 * i + (lane >> 5)) * 33 + (lane & 31)] = t[i];
    LDS_WAIT(); asm volatile("" ::: "memory");
    const int c = lane & 7;
#pragma unroll
    for (int j = 0; j < 4; ++j) { const int n = (lane >> 3) + 8 * j; const LAS float* s = scr + (8 * c) * 33 + n;
        v4u o; o.x = pk2(s[0 * 33], s[1 * 33]); o.y = pk2(s[2 * 33], s[3 * 33]); o.z = pk2(s[4 * 33], s[5 * 33]); o.w = pk2(s[6 * 33], s[7 * 33]);
        *(GAS v4u*)(WT + (size_t)(drow0 + n) * ldt + k0 + 8 * c) = o; }
    LDS_WAIT(); asm volatile("" ::: "memory");
}
__device__ __forceinline__ void cvt_matrix(const Frame& F0, const float* W, int K, int N, bf16* WT) {
    const Frame F = relaunder(F0);
    LAS float* scr = (LAS float*)(F.lds + F.wave * 16384);
    const int nblk = N / 32, nitems = (K / 64) * nblk;
    for (int it = F.gw; it < nitems; it += F.NGW) { const int kb = it / nblk, nb = it - kb * nblk; transpose_item(W, N, WT, K, 64 * kb, 32 * nb, 32 * nb, scr, F.lane); }
}
__device__ __forceinline__ void cvt_gates(const Frame& F0, const float* wa, const float* wi, bf16* Wg) {
    const Frame F = relaunder(F0);
    LAS float* scr = (LAS float*)(F.lds + F.wave * 16384);
    for (int it = F.gw; it < 512; it += F.NGW) { const int gsel = it >> 8, blk = (it >> 5) & 7, sub = it & 31, kb = sub >> 3, nb = sub & 7, n0 = 32 * nb;
        const float* W = (gsel ? wi : wa) + (size_t)blk * 65536;
        transpose_item(W, 256, Wg, 256, 64 * kb, n0, (2 * blk + (n0 >> 7)) * 256 + gsel * 128 + (n0 & 127), scr, F.lane); }
}
__device__ __forceinline__ void mod_gemv(const Frame& F0, const float* c, const float* w_mod, const float* kv_w_mod, float* MODP) {
    const Frame F = relaunder(F0);
    LAS float* cs = (LAS float*)(F.lds + F.wave * 16384);
    constexpr int NCG = NCOLS_MOD / 256, KR = DM / KSPLIT;
    for (int task = F.gw; task < NCG * KSPLIT; task += F.NGW) {
        const int p = task % KSPLIT, cg = task / KSPLIT, col = cg * 256, k0 = p * KR;
        const float* W; int ldw, cin;
        if (col < NLAYER * 6 * DM) { const int l = col / (6 * DM); W = w_mod + (size_t)l * DM * (6 * DM); ldw = 6 * DM; cin = col - l * 6 * DM; }
        else { W = kv_w_mod; ldw = 2 * DM; cin = col - NLAYER * 6 * DM; }
#pragma unroll
        for (int i = 0; i < 4; ++i)
#pragma unroll
            for (int b = 0; b < 2; ++b) { const float v = GP(const float, c)[b * DM + k0 + F.lane + 64 * i]; cs[b * 256 + F.lane + 64 * i] = v / (1.0f + __expf(-v)); }
        LDS_WAIT(); asm volatile("" ::: "memory");
        f32x4 a0 = {0.f, 0.f, 0.f, 0.f}, a1 = {0.f, 0.f, 0.f, 0.f};
        const float* wp = W + (size_t)k0 * ldw + cin + 4 * F.lane;
#pragma unroll 8
        for (int k = 0; k < KR; ++k) { const f32x4 w = *(const GAS f32x4*)(wp + (size_t)k * ldw); const float s0 = cs[k], s1 = cs[256 + k]; a0 += w * s0; a1 += w * s1; }
        *(GAS f32x4*)(MODP + (size_t)(p * 2 + 0) * NCOLS_MOD + col + 4 * F.lane) = a0;
        *(GAS f32x4*)(MODP + (size_t)(p * 2 + 1) * NCOLS_MOD + col + 4 * F.lane) = a1;
        LDS_WAIT(); asm volatile("" ::: "memory");
    }
}
template <bool WITH_F>
__device__ __forceinline__ void norm_rows(const Frame& F0, const float* x, const bf16* delta, const bf16* delta2, float* xout, const float* gain, const float* shift, const float* scale, bf16* out, const float* w_forget, const float* b_forget, float* logf) {
    const Frame F = relaunder(F0);
    LAS float* wfT = (LAS float*)F.lds;
    if (WITH_F) {
#pragma unroll 4
        for (int i = 0; i < 16; ++i) { const int idx = F.tid + 512 * i, d = idx >> 2, j0 = (idx & 3) * 4; const f32x4 v = *(const GAS f32x4*)(w_forget + 4 * idx);
            wfT[(j0 + 0) * DM + d] = v.x; wfT[(j0 + 1) * DM + d] = v.y; wfT[(j0 + 2) * DM + d] = v.z; wfT[(j0 + 3) * DM + d] = v.w; }
        __syncthreads();
    }
    constexpr int RPW = M / 2048;
    for (int r0 = F.gw * RPW; r0 < M; r0 += F.NGW * RPW) {
        const int b = r0 / SEQ;
        f32x4 A[8], Bv[8];
#pragma unroll
        for (int j = 0; j < 8; ++j) { const int d = 4 * (F.lane + 64 * j); const f32x4 g = *(const GAS f32x4*)(gain + d), sc = *(const GAS f32x4*)(scale + (size_t)b * NCOLS_MOD + d);
            A[j] = g * (sc + 1.0f); Bv[j] = *(const GAS f32x4*)(shift + (size_t)b * NCOLS_MOD + d); }
#pragma clang loop unroll(disable)
        for (int r = r0; r < r0 + RPW; ++r) {
            const GAS f32x4* xr = (const GAS f32x4*)(x + (size_t)r * DM) + F.lane;
            f32x4 v[8]; float s = 0.f;
#pragma unroll
            for (int j = 0; j < 8; ++j) v[j] = __builtin_nontemporal_load(xr + 64 * j);
            if (delta) {
                const GAS unsigned long long* dr = (const GAS unsigned long long*)(delta + (size_t)r * DM) + F.lane; GAS f32x4* xw = (GAS f32x4*)(xout + (size_t)r * DM) + F.lane;
                unsigned long long dq[8];
#pragma unroll
                for (int j = 0; j < 8; ++j) dq[j] = dr[64 * j];
#pragma unroll
                for (int j = 0; j < 8; ++j) { const unsigned lo = (unsigned)dq[j], hi = (unsigned)(dq[j] >> 32); v[j].x += bflo(lo); v[j].y += bfhi(lo); v[j].z += bflo(hi); v[j].w += bfhi(hi); }
                if (delta2) { const GAS unsigned long long* dr2 = (const GAS unsigned long long*)(delta2 + (size_t)r * DM) + F.lane;
#pragma unroll
                    for (int j = 0; j < 8; ++j) dq[j] = dr2[64 * j];
#pragma unroll
                    for (int j = 0; j < 8; ++j) { const unsigned lo = (unsigned)dq[j], hi = (unsigned)(dq[j] >> 32); v[j].x += bflo(lo); v[j].y += bfhi(lo); v[j].z += bflo(hi); v[j].w += bfhi(hi); } }
                if (xout) {
#pragma unroll
                    for (int j = 0; j < 8; ++j) __builtin_nontemporal_store(v[j], xw + 64 * j); }
            }
#pragma unroll
            for (int j = 0; j < 8; ++j) s += (v[j].x * v[j].x + v[j].y * v[j].y) + (v[j].z * v[j].z + v[j].w * v[j].w);
            const float rstd = 1.0f / sqrtf(wave_sum(s, F.lane) * (1.0f / DM) + NORM_EPS);
            GAS unsigned long long* o8 = (GAS unsigned long long*)(out + (size_t)r * DM) + F.lane;
#pragma unroll
            for (int j = 0; j < 8; ++j) { v[j] = (v[j] * rstd) * A[j] + Bv[j]; o8[64 * j] = (unsigned long long)pk2(v[j].x, v[j].y) | ((unsigned long long)pk2(v[j].z, v[j].w) << 32); }
            if (WITH_F) {
                float pt[16];
#pragma unroll
                for (int h = 0; h < 16; ++h) { float a = 0.f;
#pragma unroll
                    for (int j = 0; j < 8; ++j) { const f32x4 w = *(const LAS f32x4*)(wfT + h * DM + 4 * (F.lane + 64 * j)); a += (v[j].x * w.x + v[j].y * w.y) + (v[j].z * w.z + v[j].w * w.w); }
                    pt[h] = a; __builtin_amdgcn_sched_barrier(0); }
#pragma unroll
                for (int i = 0; i < 8; ++i) { const bool up = (F.lane & 32) != 0; const float send = up ? pt[i] : pt[i + 8], keep = up ? pt[i + 8] : pt[i]; pt[i] = keep + bperm(send, F.lane ^ 32); }
#pragma unroll
                for (int i = 0; i < 4; ++i) { const bool up = (F.lane & 16) != 0; const float send = up ? pt[i] : pt[i + 4], keep = up ? pt[i + 4] : pt[i]; pt[i] = keep + bperm(send, F.lane ^ 16); }
#pragma unroll
                for (int i = 0; i < 2; ++i) { const bool up = (F.lane & 8) != 0; const float send = up ? pt[i] : pt[i + 2], keep = up ? pt[i + 2] : pt[i]; pt[i] = keep + bperm(send, F.lane ^ 8); }
                { const bool up = (F.lane & 4) != 0; const float send = up ? pt[0] : pt[1], keep = up ? pt[1] : pt[0]; pt[0] = keep + bperm(send, F.lane ^ 4); }
                pt[0] += xor2(pt[0]); pt[0] += xor1(pt[0]);
                const int h = F.lane >> 2; const float z = pt[0] + GP(const float, b_forget)[h];
                const float lf = fminf(z, 0.f) - log1pf(__expf(-fabsf(z)));
                if ((F.lane & 3) == 0) GP(float, logf)[(size_t)r * 16 + h] = lf;
            }
        }
    }
    if (WITH_F) __syncthreads();
}
__device__ __forceinline__ void headnorm_rows(const Frame& F0, const bf16* src, bf16* dst, const float* g) {
    const Frame F = relaunder(F0);
    float gg[32];
#pragma unroll
    for (int i = 0; i < 32; ++i) gg[i] = GP(const float, g)[32 * (F.lane & 3) + i];
    for (int r = F.gw; r < M; r += F.NGW) {
        const GAS v4u* sp = (const GAS v4u*)(src + (size_t)r * DM + 32 * F.lane);
        v4u w[4]; float xv[32]; float s = 0.f;
#pragma unroll
        for (int q = 0; q < 4; ++q) w[q] = sp[q];
#pragma unroll
        for (int q = 0; q < 4; ++q) { xv[8 * q + 0] = bflo(w[q].x); xv[8 * q + 1] = bfhi(w[q].x); xv[8 * q + 2] = bflo(w[q].y); xv[8 * q + 3] = bfhi(w[q].y);
            xv[8 * q + 4] = bflo(w[q].z); xv[8 * q + 5] = bfhi(w[q].z); xv[8 * q + 6] = bflo(w[q].w); xv[8 * q + 7] = bfhi(w[q].w); }
#pragma unroll
        for (int i = 0; i < 32; ++i) s += xv[i] * xv[i];
        s += xor1(s); s += xor2(s);
        const float rstd = 1.0f / sqrtf(s * (1.0f / DH) + NORM_EPS);
        GAS v4u* dp = (GAS v4u*)(dst + (size_t)r * DM + 32 * F.lane);
#pragma unroll
        for (int q = 0; q < 4; ++q) { v4u o; o.x = pk2(xv[8 * q + 0] * rstd * gg[8 * q + 0], xv[8 * q + 1] * rstd * gg[8 * q + 1]); o.y = pk2(xv[8 * q + 2] * rstd * gg[8 * q + 2], xv[8 * q + 3] * rstd * gg[8 * q + 3]);
            o.z = pk2(xv[8 * q + 4] * rstd * gg[8 * q + 4], xv[8 * q + 5] * rstd * gg[8 * q + 5]); o.w = pk2(xv[8 * q + 6] * rstd * gg[8 * q + 6], xv[8 * q + 7] * rstd * gg[8 * q + 7]); dp[q] = o; }
    }
}
__device__ __forceinline__ void build_F(const Frame& F0, const float* logf, float* Fo, const float* kg, const float* qg, int* desc) {
    const Frame F = relaunder(F0);
    LAS float* wt = (LAS float*)F.lds;
    LAS float* fe = wt + 16; LAS float* fp = fe + 256; LAS float* fr = fp + 64;
    LAS float* fbuf = (LAS float*)(F.lds + 4096);
    for (int bh = F.bid; bh < BATCH * NH; bh += F.G) {
        const int b = bh / NH, h = bh % NH, s0 = 32 * F.tid;
        float v[32]; float tot = 0.f;
#pragma unroll
        for (int i = 0; i < 32; ++i) { v[i] = GP(const float, logf)[((size_t)b * SEQ + s0 + i) * 16 + h]; tot += v[i]; }
        float inc = tot;
#pragma unroll
        for (int o = 1; o < 64; o <<= 1) { const float t = bperm(inc, F.lane - o); if (F.lane >= o) inc += t; }
        if (F.lane == 63) wt[F.wave] = inc;
        __syncthreads();
        float off = inc - tot;
        for (int w = 0; w < F.wave; ++w) off += wt[w];
        float run = off;
#pragma unroll
        for (int i = 0; i < 32; ++i) { run += v[i]; fbuf[33 * F.tid + i] = run; if (i == 0 && (F.tid & 7) == 0) fp[F.tid >> 3] = run; }
        if (F.tid & 1) fe[F.tid >> 1] = run;
        if ((F.tid & 7) == 7) fr[F.tid >> 3] = run;
        __syncthreads();
#pragma unroll
        for (int k = 0; k < 8; ++k) { const int s = 4 * (F.tid + 512 * k), li = s + (s >> 5);
            *(GAS f32x4*)(Fo + (size_t)bh * SEQ + s) = (f32x4){fbuf[li], fbuf[li + 1], fbuf[li + 2], fbuf[li + 3]}; }
        if (F.tid < 64) {
            float gk = fmaxf(fabsf(GP(const float, kg)[F.tid]), fabsf(GP(const float, kg)[F.tid + 64]));
            float gq = fmaxf(fmaxf(fabsf(GP(const float, qg)[F.tid]), fabsf(GP(const float, qg)[F.tid + 64])), fmaxf(fabsf(GP(const float, qg)[F.tid + 128]), fabsf(GP(const float, qg)[F.tid + 192])));
#pragma unroll
            for (int o = 1; o < 64; o <<= 1) { gk = fmaxf(gk, bperm(gk, F.lane ^ o)); gq = fmaxf(gq, bperm(gq, F.lane ^ o)); }
            const float bound = 30.0f + 2.0f * (11.313708499f * 1.02f) * gk * gq;
            if (F.tid == 0) GP(float, (float*)desc)[2 * BATCH * NH * 64] = (float)DH * 1.02f * gk * gq + 30.0f * 11.313708499f;
            const int qb = F.tid, lim = 4 * qb; const float f0 = fp[qb];
            int lo = 0, hi = lim;
            while (lo < hi) { const int mid = (lo + hi) >> 1; if (fe[mid] - f0 > bound) lo = mid + 1; else hi = mid; }
            const int j = lo & ~1;
            GP(int, desc)[(bh * 64 + qb) * 2] = j; GP(float, (float*)desc)[(bh * 64 + qb) * 2 + 1] = fr[qb];
        }
        __syncthreads();
    }
}
__device__ __forceinline__ void conv_rows(const Frame& F0, const bf16* xb, const float* cw, const float* cb, bf16* xc) {
    const Frame F = relaunder(F0);
    constexpr int RB = 32, NT = (M / RB) * 4;
    for (int task = F.gw; task < NT; task += F.NGW) {
        const int rb = task >> 2, ch = (task & 3) * 512 + F.lane * 8, r0 = rb * RB;
        float w[4][8], bb[8];
#pragma unroll
        for (int k = 0; k < 4; ++k) { const f32x4 a = *(const GAS f32x4*)(cw + k * DM + ch), c2 = *(const GAS f32x4*)(cw + k * DM + ch + 4);
            w[k][0] = a.x; w[k][1] = a.y; w[k][2] = a.z; w[k][3] = a.w; w[k][4] = c2.x; w[k][5] = c2.y; w[k][6] = c2.z; w[k][7] = c2.w; }
        { const f32x4 a = *(const GAS f32x4*)(cb + ch), c2 = *(const GAS f32x4*)(cb + ch + 4); bb[0] = a.x; bb[1] = a.y; bb[2] = a.z; bb[3] = a.w; bb[4] = c2.x; bb[5] = c2.y; bb[6] = c2.z; bb[7] = c2.w; }
        const bool head = (r0 % SEQ) == 0;
        v4u hw[3];
#pragma unroll
        for (int k = 0; k < 3; ++k) hw[k] = head ? (v4u){0u, 0u, 0u, 0u} : *(const GAS v4u*)(xb + (size_t)(r0 - 3 + k) * DM + ch);
        float x0[8], x1[8], x2[8];
#define UNPK(dst, ww) do { dst[0] = bflo(ww.x); dst[1] = bfhi(ww.x); dst[2] = bflo(ww.y); dst[3] = bfhi(ww.y); dst[4] = bflo(ww.z); dst[5] = bfhi(ww.z); dst[6] = bflo(ww.w); dst[7] = bfhi(ww.w); } while (0)
        UNPK(x0, hw[0]); UNPK(x1, hw[1]); UNPK(x2, hw[2]);
        for (int rr = 0; rr < RB; rr += 8) {
            v4u in[8];
#pragma unroll
            for (int q = 0; q < 8; ++q) in[q] = *(const GAS v4u*)(xb + (size_t)(r0 + rr + q) * DM + ch);
#pragma unroll
            for (int q = 0; q < 8; ++q) { float x3[8], y[8]; UNPK(x3, in[q]);
#pragma unroll
                for (int e = 0; e < 8; ++e) { y[e] = bb[e] + w[0][e] * x0[e] + w[1][e] * x1[e] + w[2][e] * x2[e] + w[3][e] * x3[e]; x0[e] = x1[e]; x1[e] = x2[e]; x2[e] = x3[e]; }
                v4u o; o.x = pk2(y[0], y[1]); o.y = pk2(y[2], y[3]); o.z = pk2(y[4], y[5]); o.w = pk2(y[6], y[7]);
                *(GAS v4u*)(xc + (size_t)(r0 + rr + q) * DM + ch) = o; }
        }
#undef UNPK
    }
}
__device__ __forceinline__ void scan_carry(const Frame& F0, const float* Pc, const float* Hc, float* Cy) {
    const Frame F = relaunder(F0);
    if (F.wave != 0) return;
    for (int task = F.vcu; task < BATCH * (DM / 64); task += F.G) {
        const int b = task / (DM / 64), ch = (task % (DM / 64)) * 64 + F.lane; const int cr0 = b * (NCHUNK / BATCH);
        float h = 0.f;
        for (int c0 = 0; c0 < NCHUNK / BATCH; c0 += 16) {
            float p[16], q[16];
#pragma unroll
            for (int i = 0; i < 16; ++i) { p[i] = GP(const float, Pc)[(size_t)(cr0 + c0 + i) * DM + ch]; q[i] = GP(const float, Hc)[(size_t)(cr0 + c0 + i) * DM + ch]; }
#pragma unroll
            for (int i = 0; i < 16; ++i) { GP(float, Cy)[(size_t)(cr0 + c0 + i) * DM + ch] = h; h = p[i] * h + q[i]; }
        }
    }
}
__device__ __forceinline__ void scan_fix(const Frame& F0, const bf16* HL, const bf16* AC, const float* Cy, const bf16* yg, bf16* hs) {
    const Frame F = relaunder(F0);
    for (int task = F.gw; task < NCHUNK * 4; task += F.NGW) {
        const int cr = task >> 2, ch = (task & 3) * 512 + F.lane * 8; const size_t base = (size_t)cr * CHUNK * DM + ch;
        const f32x4 c0 = *(const GAS f32x4*)(Cy + (size_t)cr * DM + ch), c1 = *(const GAS f32x4*)(Cy + (size_t)cr * DM + ch + 4);
        const float cy[8] = {c0.x, c0.y, c0.z, c0.w, c1.x, c1.y, c1.z, c1.w};
        for (int t = 0; t < CHUNK; t += 8) {
            v4u hl[8], ac[8], g[8];
#pragma unroll
            for (int q = 0; q < 8; ++q) { hl[q] = __builtin_nontemporal_load((const GAS v4u*)(HL + base + (size_t)(t + q) * DM)); ac[q] = __builtin_nontemporal_load((const GAS v4u*)(AC + base + (size_t)(t + q) * DM)); g[q] = __builtin_nontemporal_load((const GAS v4u*)(yg + base + (size_t)(t + q) * DM)); }
#pragma unroll
            for (int q = 0; q < 8; ++q) { v4u o;
                o.x = pk2((bflo(hl[q].x) + bflo(ac[q].x) * cy[0]) * bflo(g[q].x), (bfhi(hl[q].x) + bfhi(ac[q].x) * cy[1]) * bfhi(g[q].x));
                o.y = pk2((bflo(hl[q].y) + bflo(ac[q].y) * cy[2]) * bflo(g[q].y), (bfhi(hl[q].y) + bfhi(ac[q].y) * cy[3]) * bfhi(g[q].y));
                o.z = pk2((bflo(hl[q].z) + bflo(ac[q].z) * cy[4]) * bflo(g[q].z), (bfhi(hl[q].z) + bfhi(ac[q].z) * cy[5]) * bfhi(g[q].z));
                o.w = pk2((bflo(hl[q].w) + bflo(ac[q].w) * cy[6]) * bflo(g[q].w), (bfhi(hl[q].w) + bfhi(ac[q].w) * cy[7]) * bfhi(g[q].w));
                *(GAS v4u*)(hs + base + (size_t)(t + q) * DM) = o; }
        }
    }
}
__device__ __forceinline__ fox::BlockRef fox_ref(int n, const unsigned char* ws, unsigned oQ, unsigned oK, unsigned oV, unsigned oF, unsigned oO) {
    const int qb = 63 - (n >> 5), bh = n & 31, b = bh >> 4, h = bh & 15;
    const unsigned rowb = (unsigned)(((size_t)b * SEQ * DM + (size_t)h * DH) * 2), qrow = (unsigned)((size_t)qb * 256 * DM * 2);
    fox::BlockRef r; r.q = oQ + rowb + qrow; r.o = oO + rowb + qrow; r.k = oK + rowb; r.v = oV + rowb; r.f = oF + (unsigned)(bh * SEQ * 4); r.P0 = qb * 256;
    const unsigned long long d = *(const GAS unsigned long long*)((const GAS unsigned char*)ws + WS_DESC + (size_t)(bh * 64 + qb) * 8);
    r.jlo = __builtin_amdgcn_readfirstlane((int)(unsigned)d);
#ifdef PROBE_ATT_MIN
    if (oO == (unsigned)WS_R2A) { const int nt_ = 4 * (qb + 1); r.jlo = nt_ > PROBE_ATT_MIN ? nt_ - PROBE_ATT_MIN : 0; }
#endif
    r.fref = __uint_as_float(__builtin_amdgcn_readfirstlane((unsigned)(d >> 32)));
    return r;
}
__device__ __forceinline__ void attn_phase(const Frame& F0, char* lds, const unsigned char* ws, unsigned oQ, unsigned oK, unsigned oV, unsigned oF, unsigned oO, unsigned* qctr) {
    const Frame F = relaunder(F0);
    constexpr int NITEM = BATCH * NH * 64;
    int* mbox = (int*)(lds + fox::LDS_BYTES_ATT);
    if (F.tid == 0) { mbox[2] = (int)__hip_atomic_fetch_add(qctr, 1u, __ATOMIC_RELAXED, __HIP_MEMORY_SCOPE_AGENT); mbox[3] = (int)__hip_atomic_fetch_add(qctr, 1u, __ATOMIC_RELAXED, __HIP_MEMORY_SCOPE_AGENT); }
    __syncthreads();
    int n0 = __builtin_amdgcn_readfirstlane(mbox[2]), n1 = __builtin_amdgcn_readfirstlane(mbox[3]);
    if (n0 >= NITEM) return;
    const fox::rsrc_t rs = __builtin_amdgcn_make_buffer_rsrc((void*)ws, (short)0, (int)WS_END, 0x00020000);
    fox::BlockRef cur = fox_ref(n0, ws, oQ, oK, oV, oF, oO);
    bool has_nxt = n1 < NITEM;
    fox::BlockRef nxt = has_nxt ? fox_ref(n1, ws, oQ, oK, oV, oF, oO) : cur;
    fox::Seam S;
    const float cdyn = __uint_as_float(__builtin_amdgcn_readfirstlane(__float_as_uint(*(const GAS float*)((const GAS unsigned char*)ws + WS_DESC + (size_t)BATCH * NH * 64 * 8))));
    fox::fox_prime(cur, lds, S, F.tid, rs);
    for (int it = 0;; ++it) {
        fox::fox_block(cur, nxt, lds, S, F.tid, rs, qctr, has_nxt, mbox + (it & 1), cdyn);
        if (!has_nxt) break;
        const int n2 = __builtin_amdgcn_readfirstlane(mbox[it & 1]);
        cur = nxt; has_nxt = n2 < NITEM;
        if (has_nxt) nxt = fox_ref(n2, ws, oQ, oK, oV, oF, oO);
    }
}

struct Args { const float* in[27]; float* out; unsigned char* ws; };
constexpr int PTAB_OFF = LDSCTL_OFF + 1024;
__device__ __forceinline__ unsigned long long ptab(LAS unsigned char* lds, int i) {
    LAS unsigned char* p = lds + PTAB_OFF; asm volatile("" : "+v"(p));
    const unsigned long long v = ((const LAS unsigned long long*)p)[i];
    const unsigned lo = __builtin_amdgcn_readfirstlane((unsigned)v), hi = __builtin_amdgcn_readfirstlane((unsigned)(v >> 32));
    return ((unsigned long long)hi << 32) | lo;
}
#define IN(k) ((const float*)ptab(F.lds, (k)))
#define XO() ((float*)ptab(F.lds, 27))
#define WSP(off) ((unsigned char*)ptab(F.lds, 28) + (off))
#ifdef PROBE_T
#define GRID_BAR() do { XcdBarrier b_; b_.bar = (unsigned*)(WSP(WS_CTL)) + CW_BAR; b_.x = xb_xcc_id(); b_.st = MISC + 8; xcd_barrier(b_); \
    if (blockIdx.x == 0 && threadIdx.x == 0) { volatile LAS unsigned* w_ = (volatile LAS unsigned*)(F.lds + LDSCTL_OFF + 256); const unsigned now_ = (unsigned)__builtin_amdgcn_s_memrealtime(); const unsigned c_ = w_[2]; \
        if (c_ + 1 == PROBE_T) w_[0] = now_; if (c_ == PROBE_T) __hip_atomic_store((unsigned*)(WSP(WS_CTL)) + CW_Q + 512, now_ - w_[0], __ATOMIC_RELAXED, __HIP_MEMORY_SCOPE_AGENT); w_[2] = c_ + 1; } } while (0)
#else
#define GRID_BAR() do { XcdBarrier b_; b_.bar = (unsigned*)(WSP(WS_CTL)) + CW_BAR; b_.x = xb_xcc_id(); b_.st = MISC + 8; xcd_barrier(b_); } while (0)
#endif
#define P_MODP ((float*)WSP(WS_MODP))
#define P_MOD ((float*)WSP(WS_MOD))
#define P_C8 ((float*)WSP(WS_C8))
#define P_LOGF ((float*)WSP(WS_LOGF))
#define P_FC ((float*)WSP(WS_F))
#define P_PC ((float*)WSP(WS_PC))
#define P_HC ((float*)WSP(WS_HC))
#define P_CY ((float*)WSP(WS_CARRY))
#define P_W_IN ((bf16*)WSP(WS_WMLP_IN))
#define P_W_OUT ((bf16*)WSP(WS_WMLP_OUT))
#define P_W_MA ((bf16*)WSP(WS_WMIX))
#define P_W_M8 ((bf16*)WSP(WS_WMIX + 8 * MiB))
#define P_W_MB ((bf16*)WSP(WS_WMIX_B))
#define P_W_MC ((bf16*)WSP(WS_WMIX_C))
#define P_H ((bf16*)WSP(WS_H))
#define P_HID ((bf16*)WSP(WS_R1))
#define P_HL ((bf16*)WSP(WS_R1))
#define P_AC ((bf16*)WSP(WS_R1 + 128 * MiB))
#define P_KRAW ((bf16*)WSP(WS_R1))
#define P_R2A ((bf16*)WSP(WS_R2A))
#define P_R2B ((bf16*)WSP(WS_R2B))
#define P_R2C ((bf16*)WSP(WS_R2C))
#define P_KB ((bf16*)WSP(WS_K))
#define P_VB ((bf16*)WSP(WS_V))
#ifdef PROBE_T
#define PT_BEGIN(k, cond) do { if ((k) == PROBE_T && (cond) && F.bid == 0 && F.tid == 0) { const unsigned long long t_ = __builtin_amdgcn_s_memrealtime(); ((volatile LAS unsigned*)(F.lds + LDSCTL_OFF + 256))[0] = (unsigned)t_; } } while (0)
#define PT_END(k, cond) do { if ((k) == PROBE_T && (cond) && F.bid == 0 && F.tid == 0) { const unsigned long long t_ = __builtin_amdgcn_s_memrealtime(); volatile LAS unsigned* w_ = (volatile LAS unsigned*)(F.lds + LDSCTL_OFF + 256); w_[1] = (unsigned)t_ - w_[0]; } } while (0)
#else
#define PT_BEGIN(k, cond) do { } while (0)
#define PT_END(k, cond) do { } while (0)
#endif
template <int layer>
__device__ __forceinline__ void run_layer(const Frame& F, volatile LAS unsigned* MISC, unsigned char* lds) {

#define MODL (P_MOD + layer * 6 * DM)
#define XSRC (layer == 0 ? IN(0) : (const float*)XO())
        if (layer > 0) {
            cvt_matrix(F, IN(6) + (size_t)layer * DM * FF, DM, FF, P_W_IN); cvt_matrix(F, IN(7) + (size_t)layer * DM * FF, FF, DM, P_W_OUT);
            if (layer < NA) { cvt_matrix(F, IN(8) + (size_t)layer * DM * 2 * DM, DM, 2 * DM, P_W_MA); cvt_matrix(F, IN(16) + (size_t)layer * DM * DM, DM, DM, P_W_MB);
                cvt_gates(F, IN(11) + (size_t)layer * 8 * 65536, IN(13) + (size_t)layer * 8 * 65536, P_W_MC); }
            else { cvt_matrix(F, IN(24) + (size_t)(layer - NA) * DM * DM, DM, DM, P_W_MA); cvt_matrix(F, IN(26) + (size_t)(layer - NA) * DM * DM, DM, DM, P_W_M8);
                if (layer == NA) cvt_matrix(F, IN(20), DM, 2 * DM, P_W_MB); }
            __syncthreads();
        }
#define XPREV (layer <= 1 ? IN(0) : (const float*)XO())
        if (layer == NA) { norm_rows<true>(F, XPREV, P_R2B, P_R2A, XO(), IN(17), P_MOD + NLAYER * 6 * DM, P_MOD + NLAYER * 6 * DM + DM, P_R2C, IN(22), IN(23), P_LOGF);
            norm_rows<false>(F, XO(), (const bf16*)nullptr, (const bf16*)nullptr, nullptr, IN(2) + layer * DM, MODL, MODL + DM, P_H, nullptr, nullptr, nullptr); }
        else if (layer == 0) norm_rows<false>(F, IN(0), (const bf16*)nullptr, (const bf16*)nullptr, nullptr, IN(2) + layer * DM, MODL, MODL + DM, P_H, nullptr, nullptr, nullptr);
        else norm_rows<false>(F, XPREV, P_R2B, P_R2A, XO(), IN(2) + layer * DM, MODL, MODL + DM, P_H, nullptr, nullptr, nullptr);
        GRID_BAR();
        if (layer < NA) {
            { const Frame FL = relaunder(F); pg8::Gemm g{P_H, P_W_MA, DM, DM, DM, 0}; pg8::StaticOrder S; S.init(M, 2 * DM, FL.G, FL.bid);
              pg8::EpiBf16<1> E{P_R2A, DM, 8, (size_t)(WS_R2B - WS_R2A) / 2, 8};
              pg8::gemm_phase(F.lds, g, S, E, FL.tid); }
            GRID_BAR();
            conv_rows(F, P_R2A, IN(9) + (size_t)layer * 4 * DM, IN(10) + (size_t)layer * DM, P_R2C);
            GRID_BAR();
            { const Frame FL = relaunder(F); pg8::Gemm g{P_R2C, P_W_MC, DM, 256, 256, 2}; pg8::StaticOrder S; S.init(M, 16 * 256, FL.G, FL.bid);
              pg8::EpiGate E{P_R2C, IN(12) + (size_t)layer * DM, IN(14) + (size_t)layer * DM, P_C8 + layer * DM, P_HL, P_AC, P_PC, P_HC};
              pg8::gemm_phase(F.lds, g, S, E, FL.tid); }
            GRID_BAR();
            scan_carry(F, P_PC, P_HC, P_CY);
            GRID_BAR();
            scan_fix(F, P_HL, P_AC, P_CY, P_R2B, P_R2A);
            GRID_BAR();
        } else {
            if (layer == NA) { build_F(F, P_LOGF, P_FC, IN(21), IN(25), (int*)WSP(WS_DESC));
#ifdef PROBE_REP_BF
              build_F(F, P_LOGF, P_FC, IN(21), IN(25), (int*)WSP(WS_DESC)); build_F(F, P_LOGF, P_FC, IN(21), IN(25), (int*)WSP(WS_DESC));
#endif
              const Frame FL = relaunder(F); pg8::Gemm g{P_R2C, P_W_MB, DM, DM, DM, 0}; pg8::StaticOrder S; S.init(M, 2 * DM, FL.G, FL.bid);
              pg8::EpiHeadNorm E{P_KB, DM, 8, (size_t)(WS_V - WS_K) / 2, 8, IN(21), (LAS float*)(F.lds + XCH_OFF)};
              pg8::gemm_phase(F.lds, g, S, E, FL.tid); }
            { const Frame FL = relaunder(F); pg8::Gemm g{P_H, P_W_MA, DM, DM, DM, 0}; pg8::StaticOrder S; S.init(M, DM, FL.G, FL.bid, 4);
              pg8::EpiHeadNorm E{P_R2B, DM, 0, 0, 8, IN(25) + (size_t)(layer - NA) * DH, (LAS float*)(F.lds + XCH_OFF)};
              pg8::gemm_phase(F.lds, g, S, E, FL.tid); }
            GRID_BAR();
            attn_phase(F, (char*)lds, WSP(0), (unsigned)WS_R2B, (unsigned)WS_K, (unsigned)WS_V, (unsigned)WS_F, (unsigned)WS_R2C, (unsigned*)WSP(WS_CTL) + CW_Q + 64 * (layer - NA));
            GRID_BAR();
#ifdef PROBE_REP_ATT
            attn_phase(F, (char*)lds, WSP(0), (unsigned)WS_R2B, (unsigned)WS_K, (unsigned)WS_V, (unsigned)WS_F, (unsigned)(PROBE_REP_ATT == 2 ? WS_R2A : WS_R2C), (unsigned*)WSP(WS_CTL) + CW_Q + 64 * (layer - NA + 2));
            GRID_BAR();
#endif
        }
        { const bf16* Ain = layer < NA ? P_R2A : P_R2C; const bf16* Wt = layer < NA ? P_W_MB : P_W_M8;
          const Frame FL = relaunder(F); pg8::Gemm g{Ain, Wt, DM, DM, DM, 0}; pg8::StaticOrder S; S.init(M, DM, FL.G, FL.bid, 4);
          pg8::EpiDelta E{P_R2B, MODL + 2 * DM, 0};
          pg8::gemm_phase(F.lds, g, S, E, FL.tid); }
        GRID_BAR();
#ifdef PROBE_REP_RES
        { const bf16* Ain = layer < NA ? P_R2A : P_R2C; const bf16* Wt = layer < NA ? P_W_MB : P_W_M8;
          const Frame FL = relaunder(F); pg8::Gemm g{Ain, Wt, DM, DM, DM, 0}; pg8::StaticOrder S; S.init(M, DM, FL.G, FL.bid);
          pg8::EpiResid E{XO(), (float*)WSP(WS_R1), MODL + 2 * DM, 0, nullptr};
          pg8::gemm_phase(F.lds, g, S, E, FL.tid); }
        GRID_BAR();
#endif
        norm_rows<false>(F, XSRC, P_R2B, (const bf16*)nullptr, nullptr, IN(3) + layer * DM, MODL + 3 * DM, MODL + 4 * DM, P_H, nullptr, nullptr, nullptr);
        GRID_BAR();
#pragma clang loop unroll(disable)
        for (int q = 0; q < MLP_SPLIT; ++q) {
            constexpr int MQ = M / MLP_SPLIT;
            { const Frame FL = relaunder(F); pg8::Gemm g{P_H + (size_t)q * MQ * DM, P_W_IN, DM, DM, DM, 0}; pg8::StaticOrder S; S.init(MQ, FF, FL.G, FL.bid);
              pg8::EpiBf16<2> E{P_HID, 256, 0, 0, 0, FF / 256};
              pg8::gemm_phase(F.lds, g, S, E, FL.tid); }
            GRID_BAR();
            { const Frame FL = relaunder(F); pg8::Gemm g{P_HID, P_W_OUT, 256, FF, FF, 0, 1}; pg8::StaticOrder S; S.init(MQ, DM, FL.G, FL.bid, 4);
              if (layer + 1 < NLAYER) { pg8::EpiDelta E{P_R2A + (size_t)q * MQ * DM, MODL + 5 * DM, q * MQ}; pg8::gemm_phase(F.lds, g, S, E, FL.tid); }
              else { pg8::EpiResid E{XSRC + (size_t)q * MQ * DM, XO() + (size_t)q * MQ * DM, MODL + 5 * DM, q * MQ, P_R2B + (size_t)q * MQ * DM}; pg8::gemm_phase(F.lds, g, S, E, FL.tid); } }
            if (q + 1 < MLP_SPLIT) GRID_BAR();
        }
#ifdef PROBE_REP_UP
        GRID_BAR();
        { const Frame FL = relaunder(F); pg8::Gemm g{P_H, P_W_IN, DM, DM, DM, 0};
#if PROBE_REP_UP == 4
          pg8::FixedOrder S; S.c = FL.bid;
#else
          pg8::StaticOrder S; S.init(M, FF, FL.G, FL.bid);
#endif
          pg8::EpiNull E{};
          pg8::gemm_phase(F.lds, g, S, E, FL.tid); }
#endif
        if (layer + 1 < NLAYER) GRID_BAR();
}
__global__ void __launch_bounds__(NWAVES * 64, 2) yoco_fwd(Args args) {
    extern __shared__ __attribute__((aligned(16))) unsigned char lds[];
    Frame F;
    F.lds = (LAS unsigned char*)lds;
    volatile LAS unsigned* MISC = (volatile LAS unsigned*)(F.lds + MISC_OFF);
    F.tid = threadIdx.x; F.lane = F.tid & 63; F.wave = __builtin_amdgcn_readfirstlane(F.tid >> 6); F.bid = blockIdx.x;
    F.G = gridDim.x; { const int bx = blockIdx.x; F.vcu = (F.G % 8 == 0) ? (bx % 8) * (F.G / 8) + bx / 8 : bx; }
    F.gw = F.vcu * NWAVES + F.wave; F.NGW = F.G * NWAVES;
    for (int u = F.tid; u < (LDS_BYTES - LDSCTL_OFF) / 4; u += NWAVES * 64) ((LAS unsigned*)(F.lds + LDSCTL_OFF))[u] = 0u;
    __syncthreads();
    if (F.tid == 0) { LAS unsigned long long* t = (LAS unsigned long long*)(F.lds + PTAB_OFF);
#pragma unroll
        for (int i = 0; i < 27; ++i) t[i] = (unsigned long long)args.in[i];
        t[27] = (unsigned long long)args.out; t[28] = (unsigned long long)args.ws; }
    __syncthreads();
    (void)xcd_barrier_post((unsigned*)(WSP(WS_CTL)) + CW_BAR, MISC + 8);
#ifdef PROBE_T
    if (PROBE_T == 0 && blockIdx.x == 0 && threadIdx.x == 0) ((volatile LAS unsigned*)(F.lds + LDSCTL_OFF + 256))[0] = (unsigned)__builtin_amdgcn_s_memrealtime();
#endif

    mod_gemv(F, IN(1), IN(4), IN(18), P_MODP);
    cvt_matrix(F, IN(6), DM, FF, P_W_IN); cvt_matrix(F, IN(7), FF, DM, P_W_OUT);
    cvt_matrix(F, IN(8), DM, 2 * DM, P_W_MA); cvt_matrix(F, IN(16), DM, DM, P_W_MB); cvt_gates(F, IN(11), IN(13), P_W_MC);
    GRID_BAR();
    { const float* b_mod = IN(5); const float* kv_b_mod = IN(19); const float* lam = IN(15); const float* MODP = P_MODP; float* MOD = P_MOD; float* C8 = P_C8;
      const Frame FL = relaunder(F);
      for (int i = FL.bid * (NWAVES * 64) + FL.tid; i < 2 * NCOLS_MOD; i += FL.G * NWAVES * 64) {
        const int b = i / NCOLS_MOD, col = i - b * NCOLS_MOD; float s = col < NLAYER * 6 * DM ? GP(const float, b_mod)[col] : GP(const float, kv_b_mod)[col - NLAYER * 6 * DM];
#pragma unroll
        for (int p = 0; p < KSPLIT; ++p) s += GP(const float, MODP)[(size_t)(p * 2 + b) * NCOLS_MOD + col];
        GP(float, MOD)[i] = s;
        if (i < NA * DM) GP(float, C8)[i] = -8.0f * log1pf(__expf(-GP(const float, lam)[i]));
      } }
    GRID_BAR();

    run_layer<0>(F, MISC, lds); run_layer<1>(F, MISC, lds); run_layer<2>(F, MISC, lds); run_layer<3>(F, MISC, lds);
#ifdef PROBE_T
    if (threadIdx.x == 0) { const unsigned span = __hip_atomic_load((unsigned*)(WSP(WS_CTL)) + CW_Q + 512, __ATOMIC_RELAXED, __HIP_MEMORY_SCOPE_AGENT); const unsigned long long t0 = __builtin_amdgcn_s_memrealtime();
        while (__builtin_amdgcn_s_memrealtime() - t0 < (unsigned long long)span) __builtin_amdgcn_s_sleep(8); }
#endif
}

extern "C" void kernel_launch(void* const* d_in, const int* in_sizes, int n_in, void* d_out, int out_size, void* d_ws, size_t ws_size, hipStream_t stream) {
    static int grid = 0;
    if (grid == 0) {
        if (n_in != 27 || in_sizes[0] != M * DM || out_size != M * DM || ws_size < WS_END) { fprintf(stderr, "kernel_launch: unexpected shapes (n_in %d, in0 %d, out %d, ws %zu); nothing launched\n", n_in, n_in > 0 ? in_sizes[0] : -1, out_size, ws_size); grid = -1; return; }
        int dev = 0, cus = 0, per_cu = 0;
        if (hipGetDevice(&dev) != hipSuccess || hipDeviceGetAttribute(&cus, hipDeviceAttributeMultiprocessorCount, dev) != hipSuccess) { grid = -1; return; }
        if (hipFuncSetAttribute((const void*)yoco_fwd, hipFuncAttributeMaxDynamicSharedMemorySize, LDS_BYTES) != hipSuccess) { fprintf(stderr, "kernel_launch: hipFuncSetAttribute failed\n"); grid = -1; return; }
        if (hipOccupancyMaxActiveBlocksPerMultiprocessor(&per_cu, (const void*)yoco_fwd, NWAVES * 64, LDS_BYTES) != hipSuccess || per_cu < 1) { fprintf(stderr, "kernel_launch: occupancy query says %d\n", per_cu); }
        (void)hipGetLastError();
        grid = cus;
    }
    if (grid < 0) return;
    if (hipMemsetAsync((char*)d_ws + WS_CTL, 0, CTL_ZERO_BYTES, stream) != hipSuccess) return;
    Args a{};
    for (int i = 0; i < 27; ++i) a.in[i] = (const float*)d_in[i];
    a.out = (float*)d_out; a.ws = (unsigned char*)d_ws;
    hipLaunchKernelGGL(yoco_fwd, dim3(grid), dim3(NWAVES * 64), LDS_BYTES, stream, a);
}
```

```cpp
#include <hip/hip_runtime.h>
#include <hip/hip_bf16.h>
#include <cstdio>
#include <cstdint>

constexpr int BATCH = 2, SEQ = 16384, DM = 2048, FF = 8192, NH = 16, DH = 128, NLAYER = 4, NA = 2;
constexpr int M = BATCH * SEQ;
constexpr float NORM_EPS = 1e-6f;
constexpr int NCOLS_MOD = NLAYER * 6 * DM + 2 * DM;
constexpr int KSPLIT = 8;
constexpr int NWAVES = 8;
constexpr int MLP_SPLIT = 1;
constexpr int CHUNK = 64;
constexpr int NCHUNK = M / CHUNK;

constexpr size_t MiB = 1u << 20;
constexpr size_t WS_CTL = 0, CTL_ZERO_BYTES = 1 * MiB;
constexpr size_t WS_MODP = 1 * MiB;
constexpr size_t WS_MOD = 5 * MiB;
constexpr size_t WS_C8 = 6 * MiB;
constexpr size_t WS_LOGF = 7 * MiB;
constexpr size_t WS_F = 9 * MiB;
constexpr size_t WS_PC = 11 * MiB, WS_HC = 15 * MiB, WS_CARRY = 19 * MiB;
constexpr size_t WS_WMLP_IN = 24 * MiB;
constexpr size_t WS_WMLP_OUT = 56 * MiB;
constexpr size_t WS_WMIX = 88 * MiB;
constexpr size_t WS_WMIX_B = WS_WMIX + 16 * MiB, WS_WMIX_C = WS_WMIX + 24 * MiB;
constexpr size_t WS_WKV = WS_WMIX + 16 * MiB;
constexpr size_t WS_H = 128 * MiB;
constexpr size_t WS_R1 = 256 * MiB;
constexpr size_t WS_R2A = 768 * MiB;
constexpr size_t WS_R2B = 896 * MiB;
constexpr size_t WS_R2C = 1024 * MiB;
constexpr size_t WS_K = 1152 * MiB, WS_V = 1280 * MiB;
constexpr size_t WS_END = 1408 * MiB;
constexpr size_t WS_DESC = 6 * MiB + 256 * 1024;
constexpr int CW_Q = 2048;
constexpr int CW_BAR = 4096;

constexpr int RING_BYTES = 131072;
constexpr int LDSCTL_OFF = RING_BYTES, MISC_OFF = LDSCTL_OFF + 320;
constexpr int XCH_OFF = LDSCTL_OFF + 2048;
constexpr int LDS_BYTES = 147456;

#define GAS __attribute__((address_space(1)))
#define LAS __attribute__((address_space(3)))
typedef unsigned short bf16;
typedef unsigned v4u __attribute__((ext_vector_type(4)));
typedef float f32x4 __attribute__((ext_vector_type(4)));
typedef short bf16x8 __attribute__((ext_vector_type(8)));
typedef GAS unsigned gu32;
typedef GAS unsigned long long gu64;
#define GP(T, p) ((GAS T*)(p))
#define RLX_AGENT __ATOMIC_RELAXED, __HIP_MEMORY_SCOPE_AGENT
#define LDS_WAIT() asm volatile("s_waitcnt lgkmcnt(0)" ::: "memory")
#define VM_WAIT() asm volatile("s_waitcnt vmcnt(0)" ::: "memory")
__device__ __forceinline__ unsigned long long rt() { return __builtin_amdgcn_s_memrealtime(); }
__device__ __forceinline__ unsigned f2bf(float f) { unsigned u = __builtin_bit_cast(unsigned, f); return (u + 0x7fffu + ((u >> 16) & 1u)) >> 16; }
__device__ __forceinline__ unsigned pk2(float lo, float hi) { return f2bf(lo) | (f2bf(hi) << 16); }

#define XB_TMO      128
#define XB_XCNT(j)  (256  + 64 * (j))
#define XB_XSUB(j)  (1280 + 64 * (j))
#define XB_XGEN(j)  (2304 + 64 * (j))
#define XB_TOP      3328
#define XB_TOPGEN   3392
#define XCD_BAR_WORDS 3456
#define XB_SPIN_CAP (1u << 18)

__device__ __forceinline__ unsigned xb_ld(unsigned* p)              { return __hip_atomic_load(p, __ATOMIC_RELAXED, __HIP_MEMORY_SCOPE_AGENT); }
__device__ __forceinline__ unsigned xb_add(unsigned* p, unsigned v) { return __hip_atomic_fetch_add(p, v, __ATOMIC_RELAXED, __HIP_MEMORY_SCOPE_AGENT); }
__device__ __forceinline__ unsigned xb_xcc_id() { return (unsigned)__builtin_amdgcn_s_getreg((3 << 11) | 20) & 0xFu; }
#define XB_SPIN(cond, bar) do { unsigned _sp = 0; while (cond) { __builtin_amdgcn_s_sleep(1); \
    if ((++_sp & 255u) == 0u) { if (xb_ld(&(bar)[XB_TMO])) break; if (_sp > XB_SPIN_CAP) { atomicAdd(&(bar)[XB_TMO], 1u); break; } } } } while (0)

struct XcdBarrier {
    unsigned* bar; unsigned x;
    volatile LAS unsigned* st;
};

__device__ __forceinline__ XcdBarrier xcd_barrier_post(unsigned* bar, volatile LAS unsigned* st) {
    XcdBarrier b; b.bar = bar; b.x = xb_xcc_id(); b.st = st;
    if (threadIdx.x == 0) (void)xb_add(&bar[XB_XCNT(b.x)], 1u);
    return b;
}
__device__ __forceinline__ void xcd_barrier_complete(unsigned* bar, unsigned x, unsigned& nloc, unsigned& nx) {
    const unsigned G = gridDim.x * gridDim.y * gridDim.z;
    unsigned sum, cnt, mine, sp = 0u;
    for (;;) {
        sum = 0u; cnt = 0u; mine = 0u;
#pragma unroll
        for (unsigned j = 0; j < 16; ++j) { const unsigned c = xb_ld(&bar[XB_XCNT(j)]); sum += c; cnt += (c > 0u) ? 1u : 0u; mine = (j == x) ? c : mine; }
        if (sum == G) break;
        __builtin_amdgcn_s_sleep(1);
        if ((++sp & 255u) == 0u) { if (xb_ld(&bar[XB_TMO])) break; if (sp > XB_SPIN_CAP) { atomicAdd(&bar[XB_TMO], 1u); break; } }
    }
    nloc = mine > 0u ? mine : 1u; nx = cnt > 0u ? cnt : 1u;
}

__device__ __forceinline__ void xcd_barrier(const XcdBarrier& b) {
    asm volatile("s_waitcnt vmcnt(0)" ::: "memory");
    __syncthreads();
    if (threadIdx.x == 0) {
        unsigned* bar = b.bar;
        __builtin_amdgcn_s_waitcnt(0);
        unsigned nloc = b.st[0], nx = b.st[1];
        if (nloc == 0u) { xcd_barrier_complete(bar, b.x, nloc, nx); b.st[0] = nloc; b.st[1] = nx; }
        const unsigned old = xb_add(&bar[XB_XSUB(b.x)], 1u);
        const unsigned gen = old / nloc;
        if (old + 1u == (gen + 1u) * nloc) {
            __builtin_amdgcn_fence(__ATOMIC_RELEASE, "agent");
            asm volatile("s_waitcnt vmcnt(0)" ::: "memory");
            const unsigned og = xb_add(&bar[XB_TOP], 1u);
            const unsigned tg = og / nx;
            if (og + 1u == (tg + 1u) * nx) xb_add(&bar[XB_TOPGEN], 1u);
            else XB_SPIN(xb_ld(&bar[XB_TOPGEN]) == tg, bar);
            __builtin_amdgcn_fence(__ATOMIC_ACQUIRE, "agent");
            xb_add(&bar[XB_XGEN(b.x)], 1u);
            asm volatile("s_waitcnt vmcnt(0)" ::: "memory");
        } else {
            XB_SPIN(xb_ld(&bar[XB_XGEN(b.x)]) == gen, bar);
            __builtin_amdgcn_fence(__ATOMIC_ACQUIRE, "agent");
            asm volatile("s_waitcnt vmcnt(0)" ::: "memory");
        }
    }
    __syncthreads();
}

namespace pg8 {
#define PG8_LAS __attribute__((address_space(3)))
#define PG8_GAS __attribute__((address_space(1)))
typedef unsigned short bf16_t;
typedef short bf16x8 __attribute__((ext_vector_type(8)));
typedef float f32x4 __attribute__((ext_vector_type(4)));
typedef float f32x2 __attribute__((ext_vector_type(2)));
typedef unsigned u32x4 __attribute__((ext_vector_type(4)));
typedef unsigned u32x2 __attribute__((ext_vector_type(2)));
constexpr int BM = 256, BK = 64, HALF = 128, HTB = HALF * BK * 2, STAGE_BYTES = 8 * HTB, NXCD = 8, WGM = 8;

__host__ __device__ __forceinline__ int lds_byte(int r, int c) { const int st = (r >> 4) * 2 + (c >> 5), rr = r & 15, cc = c & 31, ob = rr * 64 + cc * 2; return st * 1024 + (ob ^ (((ob >> 9) & 1) << 5)); }
__host__ __device__ __forceinline__ void stage_rc(int b, int& R, int& C) { const int st = b / 1024, sb = b % 1024, swz = sb ^ (((sb >> 9) & 1) << 5); R = (st >> 1) * 16 + swz / 64; C = (st & 1) * 32 + (swz % 64) / 2; }
__host__ __device__ __forceinline__ int perm32(int rho) { const int n = rho >> 4, i = rho & 15; return 8 * (i >> 2) + 4 * n + (i & 3); }

struct Unit { int pm, pn; };
struct Gemm { const bf16_t* A; const bf16_t* Bt; int lda, ldb, K, adiv; int atile = 0; };

struct StaticOrder {
    int nM, nN, nwg, G, c, wgm;
    __host__ __device__ void init(int M_, int N_, int G_, int c_, int wgm_ = WGM) { nM = M_ / BM; nN = N_ / BM; nwg = nM * nN; G = G_; c = c_; wgm = wgm_; }
    __host__ __device__ bool next(int i, Unit& u) const {
        const long L = (long)i * G + c; if (L >= nwg) return false;
        int wgid = (int)L; { const int q = nwg / NXCD, r = nwg % NXCD, xcd = wgid % NXCD, off = wgid / NXCD; wgid = (xcd < r ? xcd * (q + 1) : r * (q + 1) + (xcd - r) * q) + off; }
        const int nig = wgm * nN, gid = wgid / nig, fm = gid * wgm, gsz = (nM - fm) < wgm ? (nM - fm) : wgm;
        u.pm = fm + ((wgid % nig) % gsz); u.pn = (wgid % nig) / gsz; return true;
    }
};

__device__ __forceinline__ unsigned cvt_pk_bf16(float lo, float hi) { unsigned r; asm volatile("v_cvt_pk_bf16_f32 %0, %1, %2" : "=v"(r) : "v"(lo), "v"(hi)); return r; }
__device__ __forceinline__ float bf_lo(unsigned w) { return __uint_as_float(w << 16); }
__device__ __forceinline__ float bf_hi(unsigned w) { return __uint_as_float(w & 0xffff0000u); }
__device__ __forceinline__ float fast_sigmoid(float z) { return __builtin_amdgcn_rcpf(1.0f + __builtin_amdgcn_exp2f(-1.4426950408889634f * z)); }
__device__ __forceinline__ float gelu_tanh(float y) { const float z = 0.7978845608028654f * (y + 0.044715f * y * y * y); return y * fast_sigmoid(2.0f * z); }

template <int ACT> struct EpiBf16 {
    static constexpr bool PERM = true, PERMA = false;
    bf16_t* O; int ldc; int split_tiles; size_t split_stride; int act_from; int tilemajor = 0;
    __device__ __forceinline__ void operator()(const f32x4 (&acc)[2][2][4][2], const Unit& u, int wr, int wc, int fr, int fq) const {
        int pn = u.pn; bf16_t* base = O;
        if (split_tiles) { const int t = pn / split_tiles; base += (size_t)t * split_stride; pn -= t * split_tiles; }
        if (tilemajor) { base += ((size_t)u.pm * (tilemajor - 1) + pn) * (size_t)(BM * BM); pn = 0; }
        const int col0 = pn * BM + wc * 32 + 8 * fq;
        const bool act1 = (ACT == 1) && (u.pn >= act_from);
        const unsigned e0 = ((unsigned)(wr * 64 + fr) * (unsigned)ldc + (unsigned)col0) * 2u;
        char* pb = (char*)(base + (size_t)u.pm * BM * ldc);
#pragma unroll
        for (int ai = 0; ai < 2; ++ai)
#pragma unroll
            for (int m = 0; m < 4; ++m) { bf16_t* rowp = (bf16_t*)(pb + (e0 + (unsigned)((ai * HALF + m * 16) * 2) * (unsigned)ldc));
#pragma unroll
                for (int bj = 0; bj < 2; ++bj) { f32x4 v0 = acc[ai][bj][m][0], v1 = acc[ai][bj][m][1];
                    if (ACT == 1) { if (act1) {
#pragma unroll
                        for (int j = 0; j < 4; ++j) { v0[j] = gelu_tanh(v0[j]); v1[j] = gelu_tanh(v1[j]); } } }
                    if (ACT == 2) {
#pragma unroll
                        for (int j = 0; j < 4; ++j) { const float a = fmaxf(v0[j], 0.f), b = fmaxf(v1[j], 0.f); v0[j] = a * a; v1[j] = b * b; } }
                    u32x4 w; w.x = cvt_pk_bf16(v0[0], v0[1]); w.y = cvt_pk_bf16(v0[2], v0[3]); w.z = cvt_pk_bf16(v1[0], v1[1]); w.w = cvt_pk_bf16(v1[2], v1[3]);
                    if (ACT == 2 || (ACT == 1 && act1)) __builtin_nontemporal_store(w, (PG8_GAS u32x4*)((PG8_GAS bf16_t*)rowp + bj * HALF));
                    else *(PG8_GAS u32x4*)((PG8_GAS bf16_t*)rowp + bj * HALF) = w; } }
    }
};
struct EpiHeadNorm {
    static constexpr bool PERM = true, PERMA = false;
    bf16_t* O; int ldc; int split_tiles; size_t split_stride; int hn_tiles; const float* hg; PG8_LAS float* xch;
    __device__ __forceinline__ void operator()(const f32x4 (&acc)[2][2][4][2], const Unit& u, int wr, int wc, int fr, int fq) const {
        int pn = u.pn; bf16_t* base = O;
        if (split_tiles) { const int t = pn / split_tiles; base += (size_t)t * split_stride; pn -= t * split_tiles; }
        const int col0 = pn * BM + wc * 32 + 8 * fq;
        const unsigned e0 = ((unsigned)(wr * 64 + fr) * (unsigned)ldc + (unsigned)col0) * 2u;
        char* pb = (char*)(base + (size_t)u.pm * BM * ldc);
        const bool hn = u.pn < hn_tiles;
        float rs[2][4][2];
        f32x4 g0 = {1.f, 1.f, 1.f, 1.f}, g1 = {1.f, 1.f, 1.f, 1.f};
        if (hn) {
            g0 = *(const PG8_GAS f32x4*)((const PG8_GAS float*)hg + wc * 32 + 8 * fq); g1 = *(const PG8_GAS f32x4*)((const PG8_GAS float*)hg + wc * 32 + 8 * fq + 4);
            const int l16 = ((fq * 16 + fr) ^ 16) << 2;
#pragma unroll
            for (int ai = 0; ai < 2; ++ai)
#pragma unroll
                for (int m = 0; m < 4; ++m)
#pragma unroll
                    for (int bj = 0; bj < 2; ++bj) { const f32x4 a = acc[ai][bj][m][0], b = acc[ai][bj][m][1];
                        float s = (a[0] * a[0] + a[1] * a[1]) + (a[2] * a[2] + a[3] * a[3]) + (b[0] * b[0] + b[1] * b[1]) + (b[2] * b[2] + b[3] * b[3]);
                        s += __int_as_float(__builtin_amdgcn_ds_bpermute(l16, __float_as_int(s)));
                        { auto rr = __builtin_amdgcn_permlane32_swap(__float_as_uint(s), __float_as_uint(s), false, false); s = __uint_as_float(rr[0]) + __uint_as_float(rr[1]); }
                        if (fq == 0) xch[((ai * HALF + wr * 64 + m * 16 + fr) * 2 + bj) * 4 + wc] = s; }
            asm volatile("s_waitcnt lgkmcnt(0)" ::: "memory"); __builtin_amdgcn_s_barrier(); asm volatile("" ::: "memory");
#pragma unroll
            for (int ai = 0; ai < 2; ++ai)
#pragma unroll
                for (int m = 0; m < 4; ++m)
#pragma unroll
                    for (int bj = 0; bj < 2; ++bj) { const f32x4 p = *(const PG8_LAS f32x4*)(xch + ((ai * HALF + wr * 64 + m * 16 + fr) * 2 + bj) * 4);
                        rs[ai][m][bj] = __builtin_amdgcn_rsqf(((p[0] + p[1]) + (p[2] + p[3])) * (1.0f / 128.0f) + NORM_EPS); }
        } else {
#pragma unroll
            for (int ai = 0; ai < 2; ++ai)
#pragma unroll
                for (int m = 0; m < 4; ++m) { rs[ai][m][0] = 1.f; rs[ai][m][1] = 1.f; }
        }
#pragma unroll
        for (int ai = 0; ai < 2; ++ai)
#pragma unroll
            for (int m = 0; m < 4; ++m) { bf16_t* rowp = (bf16_t*)(pb + (e0 + (unsigned)((ai * HALF + m * 16) * 2) * (unsigned)ldc));
#pragma unroll
                for (int bj = 0; bj < 2; ++bj) { const f32x4 v0 = acc[ai][bj][m][0] * rs[ai][m][bj] * g0, v1 = acc[ai][bj][m][1] * rs[ai][m][bj] * g1;
                    u32x4 w; w.x = cvt_pk_bf16(v0[0], v0[1]); w.y = cvt_pk_bf16(v0[2], v0[3]); w.z = cvt_pk_bf16(v1[0], v1[1]); w.w = cvt_pk_bf16(v1[2], v1[3]);
                    *(PG8_GAS u32x4*)((PG8_GAS bf16_t*)rowp + bj * HALF) = w; } }
    }
};
struct EpiDelta {
    static constexpr bool PERM = true, PERMA = false;
    bf16_t* O; const float* gate; int row0;
    __device__ __forceinline__ void operator()(const f32x4 (&acc)[2][2][4][2], const Unit& u, int wr, int wc, int fr, int fq) const {
        const int col0 = u.pn * BM + wc * 32 + 8 * fq; const int b = (row0 + u.pm * BM) / SEQ;
        f32x4 gv[2][2];
#pragma unroll
        for (int bj = 0; bj < 2; ++bj)
#pragma unroll
            for (int n = 0; n < 2; ++n) gv[bj][n] = *(const PG8_GAS f32x4*)((const PG8_GAS float*)gate + (size_t)b * NCOLS_MOD + col0 + bj * HALF + 4 * n);
        const unsigned e0 = ((unsigned)(wr * 64 + fr) * DM + (unsigned)col0) * 2u;
        PG8_GAS char* pb = (PG8_GAS char*)(O + (size_t)u.pm * BM * DM);
#pragma unroll
        for (int ai = 0; ai < 2; ++ai)
#pragma unroll
            for (int m = 0; m < 4; ++m)
#pragma unroll
                for (int bj = 0; bj < 2; ++bj) { const f32x4 v0 = acc[ai][bj][m][0] * gv[bj][0], v1 = acc[ai][bj][m][1] * gv[bj][1];
                    u32x4 w; w.x = cvt_pk_bf16(v0[0], v0[1]); w.y = cvt_pk_bf16(v0[2], v0[3]); w.z = cvt_pk_bf16(v1[0], v1[1]); w.w = cvt_pk_bf16(v1[2], v1[3]);
                    *(PG8_GAS u32x4*)(pb + e0 + (unsigned)(((ai * HALF + m * 16) * DM + bj * HALF) * 2)) = w; }
    }
};
struct EpiResid {
    static constexpr bool PERM = false, PERMA = false;
    const float* base; float* out; const float* gate; int row0; const bf16_t* dlt;
    __device__ __forceinline__ void operator()(const f32x4 (&acc)[2][2][4][2], const Unit& u, int wr, int wc, int fr, int fq) const {
        const int col0 = u.pn * BM + wc * 32 + 4 * fq; const int b = (row0 + u.pm * BM) / SEQ;
        f32x4 gv[2][2];
#pragma unroll
        for (int bj = 0; bj < 2; ++bj)
#pragma unroll
            for (int n = 0; n < 2; ++n) gv[bj][n] = *(const PG8_GAS f32x4*)((const PG8_GAS float*)gate + (size_t)b * NCOLS_MOD + col0 + bj * HALF + n * 16);
        const unsigned e0 = ((unsigned)(wr * 64 + fr) * DM + (unsigned)col0) * 4u;
        const char* bb = (const char*)(base + (size_t)u.pm * BM * DM); char* ob = (char*)(out + (size_t)u.pm * BM * DM); const char* db = (const char*)(dlt + (size_t)u.pm * BM * DM);
#pragma unroll
        for (int ai = 0; ai < 2; ++ai)
#pragma unroll
            for (int m = 0; m < 4; ++m) {
#pragma unroll
                for (int bj = 0; bj < 2; ++bj)
#pragma unroll
                    for (int n = 0; n < 2; ++n) { const unsigned e = e0 + (unsigned)(((ai * HALF + m * 16) * DM + bj * HALF + n * 16) * 4);
                        f32x4 bs = *(const PG8_GAS f32x4*)((const PG8_GAS char*)bb + e);
                        if (dlt) { const u32x2 dw = *(const PG8_GAS u32x2*)((const PG8_GAS char*)db + (e >> 1)); bs += (f32x4){bf_lo(dw.x), bf_hi(dw.x), bf_lo(dw.y), bf_hi(dw.y)}; }
                        *(PG8_GAS f32x4*)((PG8_GAS char*)ob + e) = bs + gv[bj][n] * acc[ai][bj][m][n]; }
                if (m & 1) asm volatile("" ::: "memory"); }
    }
};
template <int CTRL> __device__ __forceinline__ float dpp_old(float oldv, float v) { return __int_as_float(__builtin_amdgcn_update_dpp(__float_as_int(oldv), __float_as_int(v), CTRL, 0xf, 0xf, false)); }
struct EpiGate {
    static constexpr bool PERM = true, PERMA = true;
    const bf16_t* xc; const float* b_a; const float* b_i; const float* c8; bf16_t* HL; bf16_t* AC; float* Pc; float* Hc;
    __device__ __forceinline__ void operator()(const f32x4 (&acc)[2][2][4][2], const Unit& u, int wr, int wc, int fr, int fq) const {
        const int ch0 = (u.pn >> 1) * 256 + (u.pn & 1) * 128 + wc * 32 + 8 * fq;
        const unsigned e0 = (unsigned)(wr * 64 + 4 * fr) * DM + (unsigned)ch0;
        const PG8_GAS char* xcb = (const PG8_GAS char*)(xc + (size_t)u.pm * BM * DM); PG8_GAS char* hb = (PG8_GAS char*)(HL + (size_t)u.pm * BM * DM); PG8_GAS char* ab = (PG8_GAS char*)(AC + (size_t)u.pm * BM * DM);
        f32x4 ba[2], bi[2], cc[2];
#pragma unroll
        for (int n = 0; n < 2; ++n) { ba[n] = *(const PG8_GAS f32x4*)((const PG8_GAS float*)b_a + ch0 + 4 * n); bi[n] = *(const PG8_GAS f32x4*)((const PG8_GAS float*)b_i + ch0 + 4 * n); cc[n] = *(const PG8_GAS f32x4*)((const PG8_GAS float*)c8 + ch0 + 4 * n); }
#pragma unroll
        for (int ai = 0; ai < 2; ++ai) {
            float A[4][8], H[4][8];
#pragma unroll
            for (int m = 0; m < 4; ++m) { const unsigned e = e0 + (unsigned)((ai * HALF + m) * DM);
                const u32x4 xw = *(const PG8_GAS u32x4*)(xcb + e * 2u);
                const float xv[8] = {bf_lo(xw.x), bf_hi(xw.x), bf_lo(xw.y), bf_hi(xw.y), bf_lo(xw.z), bf_hi(xw.z), bf_lo(xw.w), bf_hi(xw.w)};
#pragma unroll
                for (int n = 0; n < 2; ++n)
#pragma unroll
                    for (int j = 0; j < 4; ++j) { const float r = fast_sigmoid(acc[ai][0][m][n][j] + ba[n][j]), ig = fast_sigmoid(acc[ai][1][m][n][j] + bi[n][j]);
                        const float a = __builtin_amdgcn_exp2f(1.4426950408889634f * cc[n][j] * r);
                        A[m][4 * n + j] = a; H[m][4 * n + j] = __builtin_amdgcn_sqrtf(fmaxf(1.0f - a * a, 0.f)) * (ig * xv[4 * n + j]); } }
#pragma unroll
            for (int c = 0; c < 8; ++c) {
#pragma unroll
                for (int m = 1; m < 4; ++m) { H[m][c] = fmaf(A[m][c], H[m - 1][c], H[m][c]); A[m][c] *= A[m - 1][c]; }
                float a = A[3][c], h = H[3][c];
                { const float ap = dpp_old<0x111>(1.0f, a), hp = dpp_old<0x111>(0.0f, h); h = fmaf(a, hp, h); a *= ap; }
                { const float ap = dpp_old<0x112>(1.0f, a), hp = dpp_old<0x112>(0.0f, h); h = fmaf(a, hp, h); a *= ap; }
                { const float ap = dpp_old<0x114>(1.0f, a), hp = dpp_old<0x114>(0.0f, h); h = fmaf(a, hp, h); a *= ap; }
                { const float ap = dpp_old<0x118>(1.0f, a), hp = dpp_old<0x118>(0.0f, h); h = fmaf(a, hp, h); a *= ap; }
                const float ap = dpp_old<0x111>(1.0f, a), hp = dpp_old<0x111>(0.0f, h);
#pragma unroll
                for (int m = 0; m < 4; ++m) { H[m][c] = fmaf(A[m][c], hp, H[m][c]); A[m][c] *= ap; }
            }
#pragma unroll
            for (int m = 0; m < 4; ++m) { const unsigned e = e0 + (unsigned)((ai * HALF + m) * DM);
                u32x4 wh, wa; wh.x = cvt_pk_bf16(H[m][0], H[m][1]); wh.y = cvt_pk_bf16(H[m][2], H[m][3]); wh.z = cvt_pk_bf16(H[m][4], H[m][5]); wh.w = cvt_pk_bf16(H[m][6], H[m][7]);
                wa.x = cvt_pk_bf16(A[m][0], A[m][1]); wa.y = cvt_pk_bf16(A[m][2], A[m][3]); wa.z = cvt_pk_bf16(A[m][4], A[m][5]); wa.w = cvt_pk_bf16(A[m][6], A[m][7]);
                *(PG8_GAS u32x4*)(hb + e * 2u) = wh; *(PG8_GAS u32x4*)(ab + e * 2u) = wa; }
            if (fr == 15) { const size_t o = (size_t)(u.pm * 4 + ai * 2 + wr) * DM + ch0;
                *(PG8_GAS f32x4*)((PG8_GAS float*)Pc + o) = (f32x4){A[3][0], A[3][1], A[3][2], A[3][3]}; *(PG8_GAS f32x4*)((PG8_GAS float*)Pc + o + 4) = (f32x4){A[3][4], A[3][5], A[3][6], A[3][7]};
                *(PG8_GAS f32x4*)((PG8_GAS float*)Hc + o) = (f32x4){H[3][0], H[3][1], H[3][2], H[3][3]}; *(PG8_GAS f32x4*)((PG8_GAS float*)Hc + o + 4) = (f32x4){H[3][4], H[3][5], H[3][6], H[3][7]}; }
            asm volatile("" ::: "memory");
        }
    }
};

template <class Epi, class Sched, int A_AUX = 0>
__device__ __forceinline__ void gemm_phase(PG8_LAS unsigned char* lds, const Gemm g, const Sched& S, const Epi& E, const int tid  ) {
    const int wid = __builtin_amdgcn_readfirstlane(tid >> 6), lane = tid & 63, wr = wid >> 2, wc = wid & 3, fr = lane & 15, fq = lane >> 4;
    const int K = g.K, nt = K / BK, lda = g.lda, ldb = g.ldb;
    unsigned voffA[2], voffB[2];
#pragma unroll
    for (int i = 0; i < 2; ++i) { int R, C; stage_rc(tid * 16 + i * 8192, R, C); const int Rb = Epi::PERM ? ((R & ~31) + perm32(R & 31)) : R;
        const int Ra = Epi::PERMA ? ((R & 64) + 4 * (R & 15) + ((R >> 4) & 3)) : R;
        voffA[i] = (unsigned)(Ra * lda + C) * 2u; voffB[i] = (unsigned)(Rb * ldb + C) * 2u; }
    const size_t kstep = (size_t)(BK * 2);
    const size_t hstepA = (size_t)HALF * lda * 2, hstepB = (size_t)HALF * ldb * 2;
    const size_t tstepA = 2 * hstepA, tstepB = 2 * hstepB;
    const unsigned ldsw = (unsigned)wid * 1024u;
    const int aoff = lds_byte(wr * 64 + fr, fq * 8), boff = lds_byte(wc * 32 + fr, fq * 8);
#define PG8_SA(b, h) (((b) * 2 + (h)) * HTB)
#define PG8_SB(b, h) ((4 + (b) * 2 + (h)) * HTB)
#define PG8_STAGE_X(bufoff, gbase, voff, aux) do { _Pragma("unroll") for (int _i = 0; _i < 2; ++_i) \
        __builtin_amdgcn_global_load_lds((const PG8_GAS unsigned*)((const PG8_GAS char*)(gbase) + (voff)[_i]), (PG8_LAS unsigned*)(lds + (bufoff) + ldsw + _i * 8192), 16, 0, aux); } while (0)
#define PG8_STAGE(bufoff, gbase, voff) do { if (&(voff)[0] == &voffA[0]) { PG8_STAGE_X(bufoff, gbase, voff, A_AUX); } else { PG8_STAGE_X(bufoff, gbase, voff, 0); } } while (0)
#define PG8_LDA(dst, b, h) do { _Pragma("unroll") for (int m = 0; m < 4; ++m) _Pragma("unroll") for (int k = 0; k < 2; ++k) dst[m][k] = *(const PG8_LAS bf16x8*)(lds + PG8_SA(b, h) + aoff + m * 2048 + k * 1024); } while (0)
#define PG8_LDB(dst, b, h) do { _Pragma("unroll") for (int n = 0; n < 2; ++n) _Pragma("unroll") for (int k = 0; k < 2; ++k) dst[n][k] = *(const PG8_LAS bf16x8*)(lds + PG8_SB(b, h) + boff + n * 2048 + k * 1024); } while (0)
#define PG8_MMA(ai, bj, At, Bt) do { __builtin_amdgcn_s_setprio(1); _Pragma("unroll") for (int m = 0; m < 4; ++m) _Pragma("unroll") for (int n = 0; n < 2; ++n) _Pragma("unroll") for (int k = 0; k < 2; ++k) \
        acc[ai][bj][m][n] = __builtin_amdgcn_mfma_f32_16x16x32_bf16(Bt[n][k], At[m][k], acc[ai][bj][m][n], 0, 0, 0); __builtin_amdgcn_s_setprio(0); } while (0)
#define PG8_WAIT_V(n) asm volatile("s_waitcnt vmcnt(" #n ")" ::: "memory")
#define PG8_WAIT_L(n) asm volatile("s_waitcnt lgkmcnt(" #n ")" ::: "memory")
#define PG8_BAR __builtin_amdgcn_s_barrier()
#define PG8_SCHED __builtin_amdgcn_sched_barrier(0)
#define PG8_ABASE(u_) ((const char*)g.A + (size_t)(u_).pm * (g.atile ? (size_t)BM * K * 2 : tstepA) + (g.adiv ? (size_t)((u_).pn / g.adiv) * (size_t)K * 2 : (size_t)0))
#define PG8_KOFF(t_) (g.atile ? ((size_t)((t_) >> 2) * 131072u + (size_t)((t_) & 3) * 128u) : (size_t)(t_) * kstep)
#define PG8_BBASE(u_) ((const char*)g.Bt + (size_t)(u_).pn * tstepB)
    Unit cur, nxt; int ui = 0;
    if (!S.next(0, cur)) return;
    f32x4 acc[2][2][4][2];
#pragma unroll
    for (int a = 0; a < 2; ++a)
#pragma unroll
        for (int b = 0; b < 2; ++b)
#pragma unroll
            for (int m = 0; m < 4; ++m)
#pragma unroll
                for (int n = 0; n < 2; ++n) acc[a][b][m][n] = (f32x4){0.f, 0.f, 0.f, 0.f};
    bf16x8 At[4][2], B0[2][2], B1[2][2];
    const char* cA = PG8_ABASE(cur); const char* cB = PG8_BBASE(cur);
    PG8_STAGE(PG8_SB(0, 0), cB, voffB); PG8_STAGE(PG8_SB(0, 1), cB + hstepB, voffB); PG8_STAGE(PG8_SA(0, 0), cA, voffA); PG8_STAGE(PG8_SA(0, 1), cA + hstepA, voffA);
    if (wr == 1) PG8_BAR;
    PG8_WAIT_V(2); PG8_BAR;
    PG8_STAGE(PG8_SB(1, 0), cB + kstep, voffB); PG8_STAGE(PG8_SA(1, 0), cA + kstep, voffA); PG8_STAGE(PG8_SB(1, 1), cB + hstepB + kstep, voffB);
    PG8_WAIT_V(6); PG8_BAR;
    for (;;) {
        const bool has_next = S.next(ui + 1, nxt);
        const char* nA = has_next ? PG8_ABASE(nxt) : cA; const char* nB = has_next ? PG8_BBASE(nxt) : cB;
#pragma clang loop unroll(disable)
        for (int t = 0; t < nt; t += 2) {
            const bool last = (t == nt - 2);
            const char* a1 = cA + PG8_KOFF(t + 1);
            const char* a2 = last ? nA : cA + PG8_KOFF(t + 2); const char* b2 = last ? nB : cB + (size_t)(t + 2) * kstep;
            const char* a3 = a2 + kstep; const char* b3 = b2 + kstep;
            PG8_LDB(B0, 0, 0); PG8_LDB(B1, 0, 1); PG8_SCHED; PG8_LDA(At, 0, 0); PG8_STAGE(PG8_SA(1, 1), a1 + hstepA, voffA);
            PG8_WAIT_V(8); PG8_WAIT_L(0); PG8_BAR; PG8_MMA(0, 0, At, B0); PG8_MMA(0, 1, At, B1); PG8_BAR; PG8_SCHED;
            PG8_LDA(At, 0, 1); PG8_STAGE(PG8_SB(0, 0), b2, voffB); PG8_STAGE(PG8_SB(0, 1), b2 + hstepB, voffB); PG8_STAGE(PG8_SA(0, 0), a2, voffA);
            PG8_WAIT_V(8); PG8_WAIT_L(0); PG8_BAR; PG8_MMA(1, 0, At, B0); PG8_MMA(1, 1, At, B1); PG8_BAR; PG8_SCHED;
            PG8_LDB(B0, 1, 0); PG8_LDB(B1, 1, 1); PG8_SCHED; PG8_LDA(At, 1, 0); PG8_STAGE(PG8_SA(0, 1), a2 + hstepA, voffA);
            PG8_WAIT_V(8); PG8_WAIT_L(0); PG8_BAR; PG8_MMA(0, 0, At, B0); PG8_MMA(0, 1, At, B1); PG8_BAR; PG8_SCHED;
            PG8_LDA(At, 1, 1); PG8_STAGE(PG8_SB(1, 0), b3, voffB); PG8_STAGE(PG8_SB(1, 1), b3 + hstepB, voffB); PG8_STAGE(PG8_SA(1, 0), a3, voffA);
            PG8_WAIT_V(8); PG8_WAIT_L(0); PG8_BAR; PG8_MMA(1, 0, At, B0); PG8_MMA(1, 1, At, B1); PG8_BAR; PG8_SCHED;
        }
        if (wr == 0) PG8_BAR;
        E(acc, cur, wr, wc, fr, fq);
        if (!has_next) break;
#pragma unroll
        for (int a = 0; a < 2; ++a)
#pragma unroll
            for (int b = 0; b < 2; ++b)
#pragma unroll
                for (int m = 0; m < 4; ++m)
#pragma unroll
                    for (int n = 0; n < 2; ++n) acc[a][b][m][n] = (f32x4){0.f, 0.f, 0.f, 0.f};
        cur = nxt; cA = nA; cB = nB; ++ui;
        if (wr == 1) PG8_BAR;
    }
    PG8_WAIT_V(0);
    PG8_BAR;
#undef PG8_SA
#undef PG8_SB
#undef PG8_STAGE
#undef PG8_STAGE_X
#undef PG8_LDA
#undef PG8_LDB
#undef PG8_MMA
#undef PG8_WAIT_V
#undef PG8_WAIT_L
#undef PG8_BAR
#undef PG8_SCHED
#undef PG8_ABASE
#undef PG8_KOFF
#undef PG8_BBASE
}
}

namespace fox {
#define FOX_GAS __attribute__((address_space(1)))
using bf16 = __hip_bfloat16;
typedef short bf16x8 __attribute__((ext_vector_type(8)));
typedef short s16x4 __attribute__((ext_vector_type(4)));
typedef float f32x16 __attribute__((ext_vector_type(16)));
typedef float f32x4 __attribute__((ext_vector_type(4)));
typedef unsigned u32x4 __attribute__((ext_vector_type(4)));
constexpr int D = 128, RS = 2048;
constexpr float SCALE = 0.08838834764831845f, INV_SCALE = 11.313708498984761f;
constexpr float THR = 8.f;
constexpr int NW = 8, QBLK = 32, KVBLK = 64, QB = NW * QBLK;
constexpr int SHM_V = KVBLK * D * 2, SHM_K = KVBLK * D * 2;
constexpr int OFF_WS = 2 * SHM_V + 2 * SHM_K, OFF_F = OFF_WS + NW * 64 * 4;
constexpr int LDS_BYTES_ATT = OFF_F + 2 * 64 * 4;
constexpr unsigned WBIG = 0x40000000u;

#define KSWZ(row, colB) ((row) * 256 + ((colB) ^ (((row) & 7) << 4)))
#define SBAR() __builtin_amdgcn_sched_barrier(0)
__device__ __forceinline__ int v_st(int k, int c) { const int kk = (k & ~0xC) | ((k & 4) << 1) | ((k & 8) >> 1); return ((kk >> 3) * 4 + (c >> 5)) * 512 + ((kk & 7) * 32 + (c & 31)) * 2; }
__device__ __forceinline__ int v_rd_base(int lane) { return ((lane & 3) << 3) | (((lane >> 2) & 3) << 6) | (((lane >> 4) & 1) << 5) | (((lane >> 5) & 1) << 8); }
constexpr int v_rd_off(int d0, int ks, int half) { return d0 * 512 + ks * 4096 + half * 2048; }
__device__ __forceinline__ int crow(int r, int hi) { return (r & 3) + 8 * (r >> 2) + 4 * hi; }
__device__ __forceinline__ unsigned cvtpk(float lo, float hi) { unsigned r; asm volatile("v_cvt_pk_bf16_f32 %0, %1, %2" : "=v"(r) : "v"(lo), "v"(hi)); return r; }
__device__ __forceinline__ bf16x8 load8(const bf16* p) { return *reinterpret_cast<const bf16x8*>(p); }
__device__ __forceinline__ void mask_tile(f32x16& p0, f32x16& p1, int dq) {
    const float NEG = -__builtin_inff();
#pragma unroll
    for (int r = 0; r < 16; ++r) {
        const int c = (r & 3) + 8 * (r >> 2);
        if ((unsigned)(dq - c) >= WBIG) p0[r] = NEG;
        if ((unsigned)(dq - c - 32) >= WBIG) p1[r] = NEG;
    }
}
__device__ __forceinline__ bool partialSM(f32x16& p0, f32x16& p1, float& m_reg, float& mn, float& alpha) {
    float pmax = p0[0]; for (int r = 1; r < 16; ++r) pmax = fmaxf(pmax, p0[r]); for (int r = 0; r < 16; ++r) pmax = fmaxf(pmax, p1[r]);
    { auto rr = __builtin_amdgcn_permlane32_swap(__float_as_uint(pmax), __float_as_uint(pmax), false, false);
      pmax = fmaxf(__uint_as_float(rr[0]), __uint_as_float(rr[1])); }
    constexpr float C2 = 1.4426950408889634f * SCALE;
    if (__all((pmax - m_reg) * SCALE < -30.0f)) { mn = m_reg; alpha = 1.f; return true; }
    if (__builtin_expect(__all((pmax - m_reg) * SCALE <= THR), 1)) { mn = m_reg; alpha = 1.f; }
    else { mn = fmaxf(m_reg, pmax); alpha = __builtin_amdgcn_exp2f((m_reg - mn) * C2); m_reg = mn; }
    const float mnL = -mn * C2;
    for (int r = 0; r < 16; ++r) p0[r] = fmaf(p0[r], C2, mnL); for (int r = 0; r < 16; ++r) p1[r] = fmaf(p1[r], C2, mnL);
    for (int r = 0; r < 16; ++r) p0[r] = __builtin_amdgcn_exp2f(p0[r]);
    return false;
}
__device__ __forceinline__ void finishSM(f32x16& p0, f32x16& p1, float alpha, float& l_reg, bf16x8& pa0, bf16x8& pa1, bf16x8& pa2, bf16x8& pa3) {
    for (int r = 0; r < 16; ++r) p1[r] = __builtin_amdgcn_exp2f(p1[r]);
    float ps = 0; for (int r = 0; r < 16; ++r) ps += p0[r]; for (int r = 0; r < 16; ++r) ps += p1[r];
    { auto rr = __builtin_amdgcn_permlane32_swap(__float_as_uint(ps), __float_as_uint(ps), false, false);
      ps = __uint_as_float(rr[0]) + __uint_as_float(rr[1]); }
    l_reg = l_reg * alpha + ps;
#define PK4(P, B_, OUT) do { unsigned a0 = cvtpk(P[B_+0], P[B_+1]), a1 = cvtpk(P[B_+2], P[B_+3]);                          \
        unsigned b0 = cvtpk(P[B_+4], P[B_+5]), b1 = cvtpk(P[B_+6], P[B_+7]);                                             \
        auto r0 = __builtin_amdgcn_permlane32_swap(a0, b0, false, false); auto r1 = __builtin_amdgcn_permlane32_swap(a1, b1, false, false); \
        u32x4 w = {r0[0], r1[0], r0[1], r1[1]}; OUT = *reinterpret_cast<bf16x8*>(&w); } while (0)
    PK4(p0, 0, pa0); PK4(p0, 8, pa1); PK4(p1, 0, pa2); PK4(p1, 8, pa3);
#undef PK4
}
template <int KB>
__device__ __forceinline__ void qkt(f32x16& p0, f32x16& p1, const char* K_lds, int r32, int hi, const bf16x8* qr) {
    { const float* fb = (const float*)(K_lds + 2 * SHM_K + NW * 256 + KB * 256) + 4 * hi;
      const f32x4 a0 = *(const f32x4*)(fb), a1 = *(const f32x4*)(fb + 8), a2 = *(const f32x4*)(fb + 16), a3 = *(const f32x4*)(fb + 24);
      const f32x4 b0 = *(const f32x4*)(fb + 32), b1 = *(const f32x4*)(fb + 40), b2 = *(const f32x4*)(fb + 48), b3 = *(const f32x4*)(fb + 56);
      p0 = (f32x16){a0[0], a0[1], a0[2], a0[3], a1[0], a1[1], a1[2], a1[3], a2[0], a2[1], a2[2], a2[3], a3[0], a3[1], a3[2], a3[3]};
      p1 = (f32x16){b0[0], b0[1], b0[2], b0[3], b1[0], b1[1], b1[2], b1[3], b2[0], b2[1], b2[2], b2[3], b3[0], b3[1], b3[2], b3[3]}; }
    const char* kb[4];
#pragma unroll
    for (int dd = 0; dd < 4; ++dd) kb[dd] = K_lds + KB * SHM_K + KSWZ(r32, (dd * 16 + hi * 8) * 2);
#pragma unroll
    for (int d0 = 0; d0 < 8; ++d0) { const char* a = kb[d0 & 3] + (d0 >> 2) * 128;
        bf16x8 b0 = *reinterpret_cast<const bf16x8*>(a);
        bf16x8 b1 = *reinterpret_cast<const bf16x8*>(a + 32 * 256);
        p0 = __builtin_amdgcn_mfma_f32_32x32x16_bf16(b0, qr[d0], p0, 0, 0, 0);
        p1 = __builtin_amdgcn_mfma_f32_32x32x16_bf16(b1, qr[d0], p1, 0, 0, 0); }
}
template <int VB>
__device__ __forceinline__ void pv_tile(f32x16* o, int vb0, bf16x8 pa0, bf16x8 pa1, bf16x8 pa2, bf16x8 pa3) {
#define TRRD(dst, off) asm volatile("ds_read_b64_tr_b16 %0, %1 offset:%2" : "=&v"(dst) : "v"(vb0), "i"(off) : "memory")
#define PV_D0(d0) do { s16x4 l0, l1, l2, l3, h0, h1, h2, h3; constexpr int b_ = VB * SHM_V + v_rd_off(d0, 0, 0);  \
        TRRD(l0, b_); TRRD(h0, b_ + 2048); TRRD(l1, b_ + 4096); TRRD(h1, b_ + 6144); TRRD(l2, b_ + 8192); TRRD(h2, b_ + 10240); TRRD(l3, b_ + 12288); TRRD(h3, b_ + 14336); \
        asm volatile("s_waitcnt lgkmcnt(0)" ::: "memory"); SBAR();   \
        o[d0] = __builtin_amdgcn_mfma_f32_32x32x16_bf16(pa0, (bf16x8){l0[0], l0[1], l0[2], l0[3], h0[0], h0[1], h0[2], h0[3]}, o[d0], 0, 0, 0);   \
        o[d0] = __builtin_amdgcn_mfma_f32_32x32x16_bf16(pa1, (bf16x8){l1[0], l1[1], l1[2], l1[3], h1[0], h1[1], h1[2], h1[3]}, o[d0], 0, 0, 0);   \
        o[d0] = __builtin_amdgcn_mfma_f32_32x32x16_bf16(pa2, (bf16x8){l2[0], l2[1], l2[2], l2[3], h2[0], h2[1], h2[2], h2[3]}, o[d0], 0, 0, 0);   \
        o[d0] = __builtin_amdgcn_mfma_f32_32x32x16_bf16(pa3, (bf16x8){l3[0], l3[1], l3[2], l3[3], h3[0], h3[1], h3[2], h3[3]}, o[d0], 0, 0, 0); } while (0)
    PV_D0(0); PV_D0(1); PV_D0(2); PV_D0(3);
#undef PV_D0
#undef TRRD
}

struct BlockRef { unsigned q, k, v, f, o; int P0, jlo; float fref; };
typedef __amdgpu_buffer_rsrc_t rsrc_t;
typedef unsigned u32x4v __attribute__((ext_vector_type(4)));
struct Seam { bf16x8 qr[8]; bf16x8 st_v0, st_v1, st_k0, st_k1; float st_f; };
__device__ __forceinline__ bf16x8 bld8(rsrc_t rs, unsigned voff, unsigned soff) { return __builtin_bit_cast(bf16x8, __builtin_amdgcn_raw_buffer_load_b128(rs, (int)voff, (int)soff, 0)); }
__device__ __forceinline__ float bldf(rsrc_t rs, unsigned voff, unsigned soff) { return __uint_as_float(__builtin_amdgcn_raw_buffer_load_b32(rs, (int)voff, (int)soff, 0)); }
#define ROWS(base, k0, rr) ((base) + (unsigned)(((k0) + (rr)) * RS * 2))
#define VMW() asm volatile("s_waitcnt vmcnt(0)" ::: "memory")
#define VMWN(n) asm volatile("s_waitcnt vmcnt(%0)" :: "i"(n) : "memory")
#define SLOAD_H(Kp, Vp, Fp, k0) do { S.st_v0 = bld8(rs, toff, ROWS(Vp, k0, 0)); S.st_v1 = bld8(rs, toff, ROWS(Vp, k0, 32));              \
                         S.st_k0 = bld8(rs, toff, ROWS(Kp, k0, 0)); S.st_k1 = bld8(rs, toff, ROWS(Kp, k0, 32)); S.st_f = bldf(rs, foff, (Fp) + (unsigned)((k0) * 4)); } while (0)
#define SWRITE_HK(bf, fref_) do { *(bf16x8*)(K_lds + (bf) * SHM_K + kws) = S.st_k0; *(bf16x8*)(K_lds + (bf) * SHM_K + kws + 32 * 256) = S.st_k1; \
                         if (wid == 0) F_lds[(bf) * 64 + lane] = ((fref_) - S.st_f) * INV_SCALE; } while (0)
#define SWRITE_HV(bf) do { *(bf16x8*)(V_lds + (bf) * SHM_V + vst0) = S.st_v0; *(bf16x8*)(V_lds + (bf) * SHM_V + vst1) = S.st_v1; } while (0)
__device__ __forceinline__ void fox_prime(const BlockRef& cur, char* lds, Seam& S, const int tid, const rsrc_t rs) {
    const int wid = __builtin_amdgcn_readfirstlane(tid >> 6), lane = tid & 63, r32 = lane & 31, hi = lane >> 5;
    const int sr = tid >> 4, sc = (tid & 15) * 8, kws = KSWZ(sr, sc * 2); char* K_lds = lds + 2 * SHM_V; float* F_lds = (float*)(lds + OFF_F);
    const unsigned toff = (unsigned)(sr * RS + sc) * 2u, foff = (unsigned)(tid & 63) * 4u, qoff = (unsigned)(r32 * RS + hi * 8) * 2u;
    { const unsigned qs = cur.q + (unsigned)(wid * QBLK * RS * 2);
#pragma unroll
      for (int d0 = 0; d0 < 8; ++d0) S.qr[d0] = bld8(rs, qoff + d0 * 32, qs); }
    SLOAD_H(cur.k, cur.v, cur.f, cur.P0 + QB - KVBLK); VMW(); SWRITE_HK(0, cur.fref);
    __syncthreads();
}
__device__ __forceinline__ void fox_block(const BlockRef& cur, const BlockRef& nxt, char* lds, Seam& S, const int tid, const rsrc_t rs, unsigned* qctr, const bool pull, int* mbox, const float cdyn) {
    const int wid = __builtin_amdgcn_readfirstlane(tid >> 6), lane = tid & 63, r32 = lane & 31, hi = lane >> 5;
    const int NT = (cur.P0 + QB) / KVBLK; int NTT = NT - cur.jlo;
    const int qlo = cur.P0 + wid * QBLK, qm = qlo + r32 - 4 * hi;
    char* V_lds = lds; char* K_lds = lds + 2 * SHM_V; float* F_lds = (float*)(lds + OFF_F);
    float* ws = (float*)(lds + OFF_WS) + wid * 64; float* li_l = ws, * al_l = ws + 32;
    float m_reg = -1e30f, l_reg = 0; f32x16 o[4] = {};
    const int sr = tid >> 4, sc = (tid & 15) * 8, vst0 = v_st(sr, sc), vst1 = v_st(32 + sr, sc), kws = KSWZ(sr, sc * 2);
    const unsigned toff = (unsigned)(sr * RS + sc) * 2u, foff = (unsigned)(tid & 63) * 4u, qoff = (unsigned)(r32 * RS + hi * 8) * 2u;
    const int vb0 = (int)(uintptr_t)V_lds + v_rd_base(lane);
    const unsigned Kh = cur.k, Vh = cur.v, Fh = cur.f; const float fref = cur.fref;
#define RESC(a) do { if (__any((a) < 1.f)) { if (hi == 0) al_l[r32] = (a); asm volatile("s_waitcnt lgkmcnt(0)" ::: "memory");              \
                     for (int d_ = 0; d_ < 4; ++d_) for (int r = 0; r < 16; ++r) o[d_][r] *= al_l[crow(r, hi)]; } } while (0)
#define KBASE(t) ((NT - 1 - (t)) * KVBLK)
#define MASKT(P0_, P1_, t) do { const int kb_ = KBASE(t); if (kb_ + KVBLK - 1 > qlo) mask_tile(P0_, P1_, qm - kb_); } while (0)
    constexpr int NQL = 8;
#define SEAM_K0() do { VMWN(NQL); SWRITE_HK(0, nxt.fref); SBAR(); } while (0)
    f32x16 pA0, pA1, pB0, pB1; float mnA, mnB, alA, alB; bf16x8 pa0, pa1, pa2, pa3;
    unsigned pulled = 0x7fffffffu;
    if (pull && tid == 0) pulled = __hip_atomic_fetch_add(qctr, 1u, __ATOMIC_RELAXED, __HIP_MEMORY_SCOPE_AGENT);
    SWRITE_HV(0); SBAR();
    SLOAD_H(Kh, Vh, Fh, KBASE(1));
    SBAR(); qkt<0>(pA0, pA1, K_lds, r32, hi, S.qr);
    bool dA = false, dB = false;
    MASKT(pA0, pA1, 0); dA = partialSM(pA0, pA1, m_reg, mnA, alA);
    VMW(); SWRITE_HV(1); SWRITE_HK(1, fref);
    if (tid == 0) *mbox = (int)pulled;
    __syncthreads();
#define HALF_STEP(PX0, PX1, mnX, alX, dX, PY0, PY1, alY, dY, t, KB, VB, SB) do {                                              \
        SBAR(); qkt<KB>(PX0, PX1, K_lds, r32, hi, S.qr);                                                                      \
        if (!(dY)) { finishSM(PY0, PY1, alY, l_reg, pa0, pa1, pa2, pa3); } SBAR();                                            \
        if ((t) + 1 < NTT) { SLOAD_H(Kh, Vh, Fh, KBASE((t) + 1)); SBAR(); }                                                   \
        if (!(dY)) { pv_tile<VB>(o, vb0, pa0, pa1, pa2, pa3); } MASKT(PX0, PX1, (t)); dX = partialSM(PX0, PX1, m_reg, mnX, alX); \
        __syncthreads();                                                                                                      \
        if ((t) + 1 < NTT) { VMW(); SWRITE_HV(SB); SWRITE_HK(SB, fref); }                                                     \
        RESC(alX); __syncthreads(); } while (0)
    float mthr = -3.0e38f; float* mins = (float*)(lds + LDS_BYTES_ATT + 16);
    for (int t = 1; t + 1 < NTT; t += 2) {
        HALF_STEP(pB0, pB1, mnB, alB, dB, pA0, pA1, alA, dA, t, 1, 0, 0);
        if (t == 3) { float wm = m_reg;
            wm = fminf(wm, __int_as_float(__builtin_amdgcn_update_dpp(0, __float_as_int(wm), 0xB1, 0xf, 0xf, true))); wm = fminf(wm, __int_as_float(__builtin_amdgcn_update_dpp(0, __float_as_int(wm), 0x4E, 0xf, 0xf, true)));
            wm = fminf(wm, __int_as_float(__builtin_amdgcn_update_dpp(0, __float_as_int(wm), 0x124, 0xf, 0xf, true))); wm = fminf(wm, __int_as_float(__builtin_amdgcn_update_dpp(0, __float_as_int(wm), 0x128, 0xf, 0xf, true)));
            wm = fminf(wm, __int_as_float(__builtin_amdgcn_ds_bpermute((lane ^ 16) << 2, __float_as_int(wm))));
            if (lane == 0) mins[wid] = wm; }
        HALF_STEP(pA0, pA1, mnA, alA, dA, pB0, pB1, alB, dB, t + 1, 0, 1, 1);
        if (t >= 3) {
            if (t == 3) { float mm = mins[0];
#pragma unroll
                for (int w = 1; w < NW; ++w) mm = fminf(mm, mins[w]);
                mthr = __uint_as_float(__builtin_amdgcn_readfirstlane(__float_as_uint(mm))) - cdyn; }
            const float bfirst = __uint_as_float(__builtin_amdgcn_readfirstlane(__float_as_uint(F_lds[64])));
            if (bfirst < mthr && t + 3 < NTT) NTT = t + 3;
        }
    }
    SBAR(); qkt<1>(pB0, pB1, K_lds, r32, hi, S.qr); SBAR();
    SLOAD_H(nxt.k, nxt.v, nxt.f, nxt.P0 + QB - KVBLK); SBAR();
    { const unsigned qs = nxt.q + (unsigned)(wid * QBLK * RS * 2);
#pragma unroll
      for (int d0 = 0; d0 < 8; ++d0) S.qr[d0] = bld8(rs, qoff + d0 * 32, qs); }
    SBAR();
    if (!dA) { finishSM(pA0, pA1, alA, l_reg, pa0, pa1, pa2, pa3); SBAR();
        pv_tile<0>(o, vb0, pa0, pa1, pa2, pa3); }
    MASKT(pB0, pB1, NTT - 1); dB = partialSM(pB0, pB1, m_reg, mnB, alB); __syncthreads(); RESC(alB);
    if (!dB) { finishSM(pB0, pB1, alB, l_reg, pa0, pa1, pa2, pa3); SBAR(); pv_tile<1>(o, vb0, pa0, pa1, pa2, pa3); }
    SBAR(); SEAM_K0();
    if (hi == 0) li_l[r32] = l_reg; asm volatile("s_waitcnt lgkmcnt(0)" ::: "memory");
    float rli[16];
#pragma unroll
    for (int r = 0; r < 16; ++r) rli[r] = __builtin_amdgcn_rcpf(li_l[crow(r, hi)]);
    const unsigned ooff = (unsigned)(4 * hi * RS + r32) * 2u;
#pragma unroll
    for (int r = 0; r < 16; ++r) { const unsigned os = cur.o + (unsigned)((wid * QBLK + (r & 3) + 8 * (r >> 2)) * RS * 2);
#pragma unroll
        for (int d0 = 0; d0 < 4; ++d0) { const float v = o[d0][r] * rli[r];
            const float vn = __int_as_float(__builtin_amdgcn_update_dpp(0, __float_as_int(v), 0xB1, 0xf, 0xf, true));
            if ((r32 & 1) == 0) __builtin_amdgcn_raw_buffer_store_b32(cvtpk(v, vn), rs, (int)(ooff + d0 * 64), (int)os, 0); } }
    __syncthreads();
#undef RESC
#undef KBASE
#undef MASKT
#undef SEAM_K0
#undef HALF_STEP
}
#undef ROWS
#undef VMW
#undef VMWN
#undef SLOAD_H
#undef SWRITE_HK
#undef SWRITE_HV
#undef KSWZ
#undef SBAR
}

struct Frame {
    LAS unsigned char* lds;
    int tid, lane, wave, vcu, G, gw, NGW, bid;
};
__device__ __forceinline__ Frame relaunder(const Frame& F0) {
    Frame F; F.lds = F0.lds; int w = F0.wave, bx = F0.bid, G = F0.G;
    unsigned ones = ~0u; asm volatile("" : "+s"(ones));
    int ln = (int)__builtin_amdgcn_mbcnt_hi(ones, __builtin_amdgcn_mbcnt_lo(ones, 0u)); asm volatile("" : "+s"(w)); asm volatile("" : "+s"(bx)); asm volatile("" : "+s"(G));
    F.tid = w * 64 + ln; F.lane = ln; F.wave = w; F.bid = bx; F.G = G;
    F.vcu = (G % 8 == 0) ? (bx % 8) * (G / 8) + bx / 8 : bx; F.gw = F.vcu * NWAVES + F.wave; F.NGW = G * NWAVES; return F; }
template <int CTRL> __device__ __forceinline__ float dppf(float v) { return __int_as_float(__builtin_amdgcn_update_dpp(0, __float_as_int(v), CTRL, 0xf, 0xf, true)); }
__device__ __forceinline__ float xor1(float v) { return dppf<0xB1>(v); }
__device__ __forceinline__ float xor2(float v) { return dppf<0x4E>(v); }
__device__ __forceinline__ float bperm(float v, int srclane) { return __int_as_float(__builtin_amdgcn_ds_bpermute(srclane << 2, __float_as_int(v))); }
__device__ __forceinline__ float wave_sum(float v, int lane) {
    v += xor1(v); v += xor2(v); v += dppf<0x124>(v); v += dppf<0x128>(v);
    v += bperm(v, lane ^ 16);
    { auto rr = __builtin_amdgcn_permlane32_swap(__float_as_uint(v), __float_as_uint(v), false, false); v = __uint_as_float(rr[0]) + __uint_as_float(rr[1]); }
    return v;
}
__device__ __forceinline__ float bflo(unsigned w) { return __uint_as_float(w << 16); }
__device__ __forceinline__ float bfhi(unsigned w) { return __uint_as_float(w & 0xffff0000u); }

__device__ __forceinline__ void transpose_item(const float* W, int ldw, bf16* WT, int ldt, int k0, int n0, int drow0, LAS float* scr, int lane) {
    float t[32];
    const GAS float* wp = (const GAS float*)W + (size_t)(k0 + (lane >> 5)) * ldw + n0 + (lane & 31);
#pragma unroll
    for (int i = 0; i < 32; ++i) t[i] = wp[(size_t)(2 * i) * ldw];
#pragma unroll
    for (int i = 0; i < 32; ++i) scr[(2 * i + (lane >> 5)) * 33 + (lane & 31)] = t[i];
    LDS_WAIT(); asm volatile("" ::: "memory");
    const int c = lane & 7;
#pragma unroll
    for (int j = 0; j < 4; ++j) { const int n = (lane >> 3) + 8 * j; const LAS float* s = scr + (8 * c) * 33 + n;
        v4u o; o.x = pk2(s[0 * 33], s[1 * 33]); o.y = pk2(s[2 * 33], s[3 * 33]); o.z = pk2(s[4 * 33], s[5 * 33]); o.w = pk2(s[6 * 33], s[7 * 33]);
        *(GAS v4u*)(WT + (size_t)(drow0 + n) * ldt + k0 + 8 * c) = o; }
    LDS_WAIT(); asm volatile("" ::: "memory");
}
__device__ __forceinline__ void cvt_matrix(const Frame& F0, const float* W, int K, int N, bf16* WT) {
    const Frame F = relaunder(F0);
    LAS float* scr = (LAS float*)(F.lds + F.wave * 16384);
    const int nblk = N / 32, nitems = (K / 64) * nblk;
    for (int it = F.gw; it < nitems; it += F.NGW) { const int kb = it / nblk, nb = it - kb * nblk; transpose_item(W, N, WT, K, 64 * kb, 32 * nb, 32 * nb, scr, F.lane); }
}
__device__ __forceinline__ void cvt_gates(const Frame& F0, const float* wa, const float* wi, bf16* Wg) {
    const Frame F = relaunder(F0);
    LAS float* scr = (LAS float*)(F.lds + F.wave * 16384);
    for (int it = F.gw; it < 512; it += F.NGW) { const int gsel = it >> 8, blk = (it >> 5) & 7, sub = it & 31, kb = sub >> 3, nb = sub & 7, n0 = 32 * nb;
        const float* W = (gsel ? wi : wa) + (size_t)blk * 65536;
        transpose_item(W, 256, Wg, 256, 64 * kb, n0, (2 * blk + (n0 >> 7)) * 256 + gsel * 128 + (n0 & 127), scr, F.lane); }
}
__device__ __forceinline__ void mod_gemv(const Frame& F0, const float* c, const float* w_mod, const float* kv_w_mod, float* MODP) {
    const Frame F = relaunder(F0);
    LAS float* cs = (LAS float*)(F.lds + F.wave * 16384);
    constexpr int NCG = NCOLS_MOD / 256, KR = DM / KSPLIT;
    for (int task = F.gw; task < NCG * KSPLIT; task += F.NGW) {
        const int p = task % KSPLIT, cg = task / KSPLIT, col = cg * 256, k0 = p * KR;
        const float* W; int ldw, cin;
        if (col < NLAYER * 6 * DM) { const int l = col / (6 * DM); W = w_mod + (size_t)l * DM * (6 * DM); ldw = 6 * DM; cin = col - l * 6 * DM; }
        else { W = kv_w_mod; ldw = 2 * DM; cin = col - NLAYER * 6 * DM; }
#pragma unroll
        for (int i = 0; i < 4; ++i)
#pragma unroll
            for (int b = 0; b < 2; ++b) { const float v = GP(const float, c)[b * DM + k0 + F.lane + 64 * i]; cs[b * 256 + F.lane + 64 * i] = v / (1.0f + __expf(-v)); }
        LDS_WAIT(); asm volatile("" ::: "memory");
        f32x4 a0 = {0.f, 0.f, 0.f, 0.f}, a1 = {0.f, 0.f, 0.f, 0.f};
        const float* wp = W + (size_t)k0 * ldw + cin + 4 * F.lane;
#pragma unroll 8
        for (int k = 0; k < KR; ++k) { const f32x4 w = *(const GAS f32x4*)(wp + (size_t)k * ldw); const float s0 = cs[k], s1 = cs[256 + k]; a0 += w * s0; a1 += w * s1; }
        *(GAS f32x4*)(MODP + (size_t)(p * 2 + 0) * NCOLS_MOD + col + 4 * F.lane) = a0;
        *(GAS f32x4*)(MODP + (size_t)(p * 2 + 1) * NCOLS_MOD + col + 4 * F.lane) = a1;
        LDS_WAIT(); asm volatile("" ::: "memory");
    }
}
template <bool WITH_F>
__device__ __forceinline__ void norm_rows(const Frame& F0, const float* x, const bf16* delta, const bf16* delta2, float* xout, const float* gain, const float* shift, const float* scale, bf16* out, const float* w_forget, const float* b_forget, float* logf) {
    const Frame F = relaunder(F0);
    LAS float* wfT = (LAS float*)F.lds;
    if (WITH_F) {
#pragma unroll 4
        for (int i = 0; i < 16; ++i) { const int idx = F.tid + 512 * i, d = idx >> 2, j0 = (idx & 3) * 4; const f32x4 v = *(const GAS f32x4*)(w_forget + 4 * idx);
            wfT[(j0 + 0) * DM + d] = v.x; wfT[(j0 + 1) * DM + d] = v.y; wfT[(j0 + 2) * DM + d] = v.z; wfT[(j0 + 3) * DM + d] = v.w; }
        __syncthreads();
    }
    constexpr int RPW = M / 2048;
    for (int r0 = F.gw * RPW; r0 < M; r0 += F.NGW * RPW) {
        const int b = r0 / SEQ;
        f32x4 A[8], Bv[8];
#pragma unroll
        for (int j = 0; j < 8; ++j) { const int d = 4 * (F.lane + 64 * j); const f32x4 g = *(const GAS f32x4*)(gain + d), sc = *(const GAS f32x4*)(scale + (size_t)b * NCOLS_MOD + d);
            A[j] = g * (sc + 1.0f); Bv[j] = *(const GAS f32x4*)(shift + (size_t)b * NCOLS_MOD + d); }
#pragma clang loop unroll(disable)
        for (int r = r0; r < r0 + RPW; ++r) {
            const GAS f32x4* xr = (const GAS f32x4*)(x + (size_t)r * DM) + F.lane;
            f32x4 v[8]; float s = 0.f;
#pragma unroll
            for (int j = 0; j < 8; ++j) v[j] = __builtin_nontemporal_load(xr + 64 * j);
            if (delta) {
                const GAS unsigned long long* dr = (const GAS unsigned long long*)(delta + (size_t)r * DM) + F.lane; GAS f32x4* xw = (GAS f32x4*)(xout + (size_t)r * DM) + F.lane;
                unsigned long long dq[8];
#pragma unroll
                for (int j = 0; j < 8; ++j) dq[j] = dr[64 * j];
#pragma unroll
                for (int j = 0; j < 8; ++j) { const unsigned lo = (unsigned)dq[j], hi = (unsigned)(dq[j] >> 32); v[j].x += bflo(lo); v[j].y += bfhi(lo); v[j].z += bflo(hi); v[j].w += bfhi(hi); }
                if (delta2) { const GAS unsigned long long* dr2 = (const GAS unsigned long long*)(delta2 + (size_t)r * DM) + F.lane;
#pragma unroll
                    for (int j = 0; j < 8; ++j) dq[j] = dr2[64 * j];
#pragma unroll
                    for (int j = 0; j < 8; ++j) { const unsigned lo = (unsigned)dq[j], hi = (unsigned)(dq[j] >> 32); v[j].x += bflo(lo); v[j].y += bfhi(lo); v[j].z += bflo(hi); v[j].w += bfhi(hi); } }
                if (xout) {
#pragma unroll
                    for (int j = 0; j < 8; ++j) __builtin_nontemporal_store(v[j], xw + 64 * j); }
            }
#pragma unroll
            for (int j = 0; j < 8; ++j) s += (v[j].x * v[j].x + v[j].y * v[j].y) + (v[j].z * v[j].z + v[j].w * v[j].w);
            const float rstd = 1.0f / sqrtf(wave_sum(s, F.lane) * (1.0f / DM) + NORM_EPS);
            GAS unsigned long long* o8 = (GAS unsigned long long*)(out + (size_t)r * DM) + F.lane;
#pragma unroll
            for (int j = 0; j < 8; ++j) { v[j] = (v[j] * rstd) * A[j] + Bv[j]; o8[64 * j] = (unsigned long long)pk2(v[j].x, v[j].y) | ((unsigned long long)pk2(v[j].z, v[j].w) << 32); }
            if (WITH_F) {
                float pt[16];
#pragma unroll
                for (int h = 0; h < 16; ++h) { float a = 0.f;
#pragma unroll
                    for (int j = 0; j < 8; ++j) { const f32x4 w = *(const LAS f32x4*)(wfT + h * DM + 4 * (F.lane + 64 * j)); a += (v[j].x * w.x + v[j].y * w.y) + (v[j].z * w.z + v[j].w * w.w); }
                    pt[h] = a; __builtin_amdgcn_sched_barrier(0); }
#pragma unroll
                for (int i = 0; i < 8; ++i) { const bool up = (F.lane & 32) != 0; const float send = up ? pt[i] : pt[i + 8], keep = up ? pt[i + 8] : pt[i]; pt[i] = keep + bperm(send, F.lane ^ 32); }
#pragma unroll
                for (int i = 0; i < 4; ++i) { const bool up = (F.lane & 16) != 0; const float send = up ? pt[i] : pt[i + 4], keep = up ? pt[i + 4] : pt[i]; pt[i] = keep + bperm(send, F.lane ^ 16); }
#pragma unroll
                for (int i = 0; i < 2; ++i) { const bool up = (F.lane & 8) != 0; const float send = up ? pt[i] : pt[i + 2], keep = up ? pt[i + 2] : pt[i]; pt[i] = keep + bperm(send, F.lane ^ 8); }
                { const bool up = (F.lane & 4) != 0; const float send = up ? pt[0] : pt[1], keep = up ? pt[1] : pt[0]; pt[0] = keep + bperm(send, F.lane ^ 4); }
                pt[0] += xor2(pt[0]); pt[0] += xor1(pt[0]);
                const int h = F.lane >> 2; const float z = pt[0] + GP(const float, b_forget)[h];
                const float lf = fminf(z, 0.f) - log1pf(__expf(-fabsf(z)));
                if ((F.lane & 3) == 0) GP(float, logf)[(size_t)r * 16 + h] = lf;
            }
        }
    }
    if (WITH_F) __syncthreads();
}
__device__ __forceinline__ void headnorm_rows(const Frame& F0, const bf16* src, bf16* dst, const float* g) {
    const Frame F = relaunder(F0);
    float gg[32];
#pragma unroll
    for (int i = 0; i < 32; ++i) gg[i] = GP(const float, g)[32 * (F.lane & 3) + i];
    for (int r = F.gw; r < M; r += F.NGW) {
        const GAS v4u* sp = (const GAS v4u*)(src + (size_t)r * DM + 32 * F.lane);
        v4u w[4]; float xv[32]; float s = 0.f;
#pragma unroll
        for (int q = 0; q < 4; ++q) w[q] = sp[q];
#pragma unroll
        for (int q = 0; q < 4; ++q) { xv[8 * q + 0] = bflo(w[q].x); xv[8 * q + 1] = bfhi(w[q].x); xv[8 * q + 2] = bflo(w[q].y); xv[8 * q + 3] = bfhi(w[q].y);
            xv[8 * q + 4] = bflo(w[q].z); xv[8 * q + 5] = bfhi(w[q].z); xv[8 * q + 6] = bflo(w[q].w); xv[8 * q + 7] = bfhi(w[q].w); }
#pragma unroll
        for (int i = 0; i < 32; ++i) s += xv[i] * xv[i];
        s += xor1(s); s += xor2(s);
        const float rstd = 1.0f / sqrtf(s * (1.0f / DH) + NORM_EPS);
        GAS v4u* dp = (GAS v4u*)(dst + (size_t)r * DM + 32 * F.lane);
#pragma unroll
        for (int q = 0; q < 4; ++q) { v4u o; o.x = pk2(xv[8 * q + 0] * rstd * gg[8 * q + 0], xv[8 * q + 1] * rstd * gg[8 * q + 1]); o.y = pk2(xv[8 * q + 2] * rstd * gg[8 * q + 2], xv[8 * q + 3] * rstd * gg[8 * q + 3]);
            o.z = pk2(xv[8 * q + 4] * rstd * gg[8 * q + 4], xv[8 * q + 5] * rstd * gg[8 * q + 5]); o.w = pk2(xv[8 * q + 6] * rstd * gg[8 * q + 6], xv[8 * q + 7] * rstd * gg[8 * q + 7]); dp[q] = o; }
    }
}
__device__ __forceinline__ void build_F(const Frame& F0, const float* logf, float* Fo, const float* kg, const float* qg, int* desc) {
    const Frame F = relaunder(F0);
    LAS float* wt = (LAS float*)F.lds;
    LAS float* fe = wt + 16; LAS float* fp = fe + 256; LAS float* fr = fp + 64;
    LAS float* fbuf = (LAS float*)(F.lds + 4096);
    for (int bh = F.bid; bh < BATCH * NH; bh += F.G) {
        const int b = bh / NH, h = bh % NH, s0 = 32 * F.tid;
        float v[32]; float tot = 0.f;
#pragma unroll
        for (int i = 0; i < 32; ++i) { v[i] = GP(const float, logf)[((size_t)b * SEQ + s0 + i) * 16 + h]; tot += v[i]; }
        float inc = tot;
#pragma unroll
        for (int o = 1; o < 64; o <<= 1) { const float t = bperm(inc, F.lane - o); if (F.lane >= o) inc += t; }
        if (F.lane == 63) wt[F.wave] = inc;
        __syncthreads();
        float off = inc - tot;
        for (int w = 0; w < F.wave; ++w) off += wt[w];
        float run = off;
#pragma unroll
        for (int i = 0; i < 32; ++i) { run += v[i]; fbuf[33 * F.tid + i] = run; if (i == 0 && (F.tid & 7) == 0) fp[F.tid >> 3] = run; }
        if (F.tid & 1) fe[F.tid >> 1] = run;
        if ((F.tid & 7) == 7) fr[F.tid >> 3] = run;
        __syncthreads();
#pragma unroll
        for (int k = 0; k < 8; ++k) { const int s = 4 * (F.tid + 512 * k), li = s + (s >> 5);
            *(GAS f32x4*)(Fo + (size_t)bh * SEQ + s) = (f32x4){fbuf[li], fbuf[li + 1], fbuf[li + 2], fbuf[li + 3]}; }
        if (F.tid < 64) {
            float gk = fmaxf(fabsf(GP(const float, kg)[F.tid]), fabsf(GP(const float, kg)[F.tid + 64]));
            float gq = fmaxf(fmaxf(fabsf(GP(const float, qg)[F.tid]), fabsf(GP(const float, qg)[F.tid + 64])), fmaxf(fabsf(GP(const float, qg)[F.tid + 128]), fabsf(GP(const float, qg)[F.tid + 192])));
#pragma unroll
            for (int o = 1; o < 64; o <<= 1) { gk = fmaxf(gk, bperm(gk, F.lane ^ o)); gq = fmaxf(gq, bperm(gq, F.lane ^ o)); }
            const float bound = 30.0f + 2.0f * (11.313708499f * 1.02f) * gk * gq;
            if (F.tid == 0) GP(float, (float*)desc)[2 * BATCH * NH * 64] = (float)DH * 1.02f * gk * gq + 30.0f * 11.313708499f;
            const int qb = F.tid, lim = 4 * qb; const float f0 = fp[qb];
            int lo = 0, hi = lim;
            while (lo < hi) { const int mid = (lo + hi) >> 1; if (fe[mid] - f0 > bound) lo = mid + 1; else hi = mid; }
            const int j = lo & ~1;
            GP(int, desc)[(bh * 64 + qb) * 2] = j; GP(float, (float*)desc)[(bh * 64 + qb) * 2 + 1] = fr[qb];
        }
        __syncthreads();
    }
}
__device__ __forceinline__ void conv_rows(const Frame& F0, const bf16* xb, const float* cw, const float* cb, bf16* xc) {
    const Frame F = relaunder(F0);
    constexpr int RB = 32, NT = (M / RB) * 4;
    for (int task = F.gw; task < NT; task += F.NGW) {
        const int rb = task >> 2, ch = (task & 3) * 512 + F.lane * 8, r0 = rb * RB;
        float w[4][8], bb[8];
#pragma unroll
        for (int k = 0; k < 4; ++k) { const f32x4 a = *(const GAS f32x4*)(cw + k * DM + ch), c2 = *(const GAS f32x4*)(cw + k * DM + ch + 4);
            w[k][0] = a.x; w[k][1] = a.y; w[k][2] = a.z; w[k][3] = a.w; w[k][4] = c2.x; w[k][5] = c2.y; w[k][6] = c2.z; w[k][7] = c2.w; }
        { const f32x4 a = *(const GAS f32x4*)(cb + ch), c2 = *(const GAS f32x4*)(cb + ch + 4); bb[0] = a.x; bb[1] = a.y; bb[2] = a.z; bb[3] = a.w; bb[4] = c2.x; bb[5] = c2.y; bb[6] = c2.z; bb[7] = c2.w; }
        const bool head = (r0 % SEQ) == 0;
        v4u hw[3];
#pragma unroll
        for (int k = 0; k < 3; ++k) hw[k] = head ? (v4u){0u, 0u, 0u, 0u} : *(const GAS v4u*)(xb + (size_t)(r0 - 3 + k) * DM + ch);
        float x0[8], x1[8], x2[8];
#define UNPK(dst, ww) do { dst[0] = bflo(ww.x); dst[1] = bfhi(ww.x); dst[2] = bflo(ww.y); dst[3] = bfhi(ww.y); dst[4] = bflo(ww.z); dst[5] = bfhi(ww.z); dst[6] = bflo(ww.w); dst[7] = bfhi(ww.w); } while (0)
        UNPK(x0, hw[0]); UNPK(x1, hw[1]); UNPK(x2, hw[2]);
        for (int rr = 0; rr < RB; rr += 8) {
            v4u in[8];
#pragma unroll
            for (int q = 0; q < 8; ++q) in[q] = *(const GAS v4u*)(xb + (size_t)(r0 + rr + q) * DM + ch);
#pragma unroll
            for (int q = 0; q < 8; ++q) { float x3[8], y[8]; UNPK(x3, in[q]);
#pragma unroll
                for (int e = 0; e < 8; ++e) { y[e] = bb[e] + w[0][e] * x0[e] + w[1][e] * x1[e] + w[2][e] * x2[e] + w[3][e] * x3[e]; x0[e] = x1[e]; x1[e] = x2[e]; x2[e] = x3[e]; }
                v4u o; o.x = pk2(y[0], y[1]); o.y = pk2(y[2], y[3]); o.z = pk2(y[4], y[5]); o.w = pk2(y[6], y[7]);
                *(GAS v4u*)(xc + (size_t)(r0 + rr + q) * DM + ch) = o; }
        }
#undef UNPK
    }
}
__device__ __forceinline__ void scan_carry(const Frame& F0, const float* Pc, const float* Hc, float* Cy) {
    const Frame F = relaunder(F0);
    if (F.wave != 0) return;
    for (int task = F.vcu; task < BATCH * (DM / 64); task += F.G) {
        const int b = task / (DM / 64), ch = (task % (DM / 64)) * 64 + F.lane; const int cr0 = b * (NCHUNK / BATCH);
        float h = 0.f;
        for (int c0 = 0; c0 < NCHUNK / BATCH; c0 += 16) {
            float p[16], q[16];
#pragma unroll
            for (int i = 0; i < 16; ++i) { p[i] = GP(const float, Pc)[(size_t)(cr0 + c0 + i) * DM + ch]; q[i] = GP(const float, Hc)[(size_t)(cr0 + c0 + i) * DM + ch]; }
#pragma unroll
            for (int i = 0; i < 16; ++i) { GP(float, Cy)[(size_t)(cr0 + c0 + i) * DM + ch] = h; h = p[i] * h + q[i]; }
        }
    }
}
__device__ __forceinline__ void scan_fix(const Frame& F0, const bf16* HL, const bf16* AC, const float* Cy, const bf16* yg, bf16* hs) {
    const Frame F = relaunder(F0);
    for (int task = F.gw; task < NCHUNK * 4; task += F.NGW) {
        const int cr = task >> 2, ch = (task & 3) * 512 + F.lane * 8; const size_t base = (size_t)cr * CHUNK * DM + ch;
        const f32x4 c0 = *(const GAS f32x4*)(Cy + (size_t)cr * DM + ch), c1 = *(const GAS f32x4*)(Cy + (size_t)cr * DM + ch + 4);
        const float cy[8] = {c0.x, c0.y, c0.z, c0.w, c1.x, c1.y, c1.z, c1.w};
        for (int t = 0; t < CHUNK; t += 8) {
            v4u hl[8], ac[8], g[8];
#pragma unroll
            for (int q = 0; q < 8; ++q) { hl[q] = __builtin_nontemporal_load((const GAS v4u*)(HL + base + (size_t)(t + q) * DM)); ac[q] = __builtin_nontemporal_load((const GAS v4u*)(AC + base + (size_t)(t + q) * DM)); g[q] = __builtin_nontemporal_load((const GAS v4u*)(yg + base + (size_t)(t + q) * DM)); }
#pragma unroll
            for (int q = 0; q < 8; ++q) { v4u o;
                o.x = pk2((bflo(hl[q].x) + bflo(ac[q].x) * cy[0]) * bflo(g[q].x), (bfhi(hl[q].x) + bfhi(ac[q].x) * cy[1]) * bfhi(g[q].x));
                o.y = pk2((bflo(hl[q].y) + bflo(ac[q].y) * cy[2]) * bflo(g[q].y), (bfhi(hl[q].y) + bfhi(ac[q].y) * cy[3]) * bfhi(g[q].y));
                o.z = pk2((bflo(hl[q].z) + bflo(ac[q].z) * cy[4]) * bflo(g[q].z), (bfhi(hl[q].z) + bfhi(ac[q].z) * cy[5]) * bfhi(g[q].z));
                o.w = pk2((bflo(hl[q].w) + bflo(ac[q].w) * cy[6]) * bflo(g[q].w), (bfhi(hl[q].w) + bfhi(ac[q].w) * cy[7]) * bfhi(g[q].w));
                *(GAS v4u*)(hs + base + (size_t)(t + q) * DM) = o; }
        }
    }
}
__device__ __forceinline__ fox::BlockRef fox_ref(int n, const unsigned char* ws, unsigned oQ, unsigned oK, unsigned oV, unsigned oF, unsigned oO) {
    const int qb = 63 - (n >> 5), bh = n & 31, b = bh >> 4, h = bh & 15;
    const unsigned rowb = (unsigned)(((size_t)b * SEQ * DM + (size_t)h * DH) * 2), qrow = (unsigned)((size_t)qb * 256 * DM * 2);
    fox::BlockRef r; r.q = oQ + rowb + qrow; r.o = oO + rowb + qrow; r.k = oK + rowb; r.v = oV + rowb; r.f = oF + (unsigned)(bh * SEQ * 4); r.P0 = qb * 256;
    const unsigned long long d = *(const GAS unsigned long long*)((const GAS unsigned char*)ws + WS_DESC + (size_t)(bh * 64 + qb) * 8);
    r.jlo = __builtin_amdgcn_readfirstlane((int)(unsigned)d);
    r.fref = __uint_as_float(__builtin_amdgcn_readfirstlane((unsigned)(d >> 32)));
    return r;
}
__device__ __forceinline__ void attn_phase(const Frame& F0, char* lds, const unsigned char* ws, unsigned oQ, unsigned oK, unsigned oV, unsigned oF, unsigned oO, unsigned* qctr) {
    const Frame F = relaunder(F0);
    constexpr int NITEM = BATCH * NH * 64;
    int* mbox = (int*)(lds + fox::LDS_BYTES_ATT);
    if (F.tid == 0) { mbox[2] = (int)__hip_atomic_fetch_add(qctr, 1u, __ATOMIC_RELAXED, __HIP_MEMORY_SCOPE_AGENT); mbox[3] = (int)__hip_atomic_fetch_add(qctr, 1u, __ATOMIC_RELAXED, __HIP_MEMORY_SCOPE_AGENT); }
    __syncthreads();
    int n0 = __builtin_amdgcn_readfirstlane(mbox[2]), n1 = __builtin_amdgcn_readfirstlane(mbox[3]);
    if (n0 >= NITEM) return;
    const fox::rsrc_t rs = __builtin_amdgcn_make_buffer_rsrc((void*)ws, (short)0, (int)WS_END, 0x00020000);
    fox::BlockRef cur = fox_ref(n0, ws, oQ, oK, oV, oF, oO);
    bool has_nxt = n1 < NITEM;
    fox::BlockRef nxt = has_nxt ? fox_ref(n1, ws, oQ, oK, oV, oF, oO) : cur;
    fox::Seam S;
    const float cdyn = __uint_as_float(__builtin_amdgcn_readfirstlane(__float_as_uint(*(const GAS float*)((const GAS unsigned char*)ws + WS_DESC + (size_t)BATCH * NH * 64 * 8))));
    fox::fox_prime(cur, lds, S, F.tid, rs);
    for (int it = 0;; ++it) {
        fox::fox_block(cur, nxt, lds, S, F.tid, rs, qctr, has_nxt, mbox + (it & 1), cdyn);
        if (!has_nxt) break;
        const int n2 = __builtin_amdgcn_readfirstlane(mbox[it & 1]);
        cur = nxt; has_nxt = n2 < NITEM;
        if (has_nxt) nxt = fox_ref(n2, ws, oQ, oK, oV, oF, oO);
    }
}

struct Args { const float* in[27]; float* out; unsigned char* ws; };
constexpr int PTAB_OFF = LDSCTL_OFF + 1024;
__device__ __forceinline__ unsigned long long ptab(LAS unsigned char* lds, int i) {
    LAS unsigned char* p = lds + PTAB_OFF; asm volatile("" : "+v"(p));
    const unsigned long long v = ((const LAS unsigned long long*)p)[i];
    const unsigned lo = __builtin_amdgcn_readfirstlane((unsigned)v), hi = __builtin_amdgcn_readfirstlane((unsigned)(v >> 32));
    return ((unsigned long long)hi << 32) | lo;
}
#define IN(k) ((const float*)ptab(F.lds, (k)))
#define XO() ((float*)ptab(F.lds, 27))
#define WSP(off) ((unsigned char*)ptab(F.lds, 28) + (off))
#define GRID_BAR() do { XcdBarrier b_; b_.bar = (unsigned*)(WSP(WS_CTL)) + CW_BAR; b_.x = xb_xcc_id(); b_.st = MISC + 8; xcd_barrier(b_); } while (0)
#define P_MODP ((float*)WSP(WS_MODP))
#define P_MOD ((float*)WSP(WS_MOD))
#define P_C8 ((float*)WSP(WS_C8))
#define P_LOGF ((float*)WSP(WS_LOGF))
#define P_FC ((float*)WSP(WS_F))
#define P_PC ((float*)WSP(WS_PC))
#define P_HC ((float*)WSP(WS_HC))
#define P_CY ((float*)WSP(WS_CARRY))
#define P_W_IN ((bf16*)WSP(WS_WMLP_IN))
#define P_W_OUT ((bf16*)WSP(WS_WMLP_OUT))
#define P_W_MA ((bf16*)WSP(WS_WMIX))
#define P_W_M8 ((bf16*)WSP(WS_WMIX + 8 * MiB))
#define P_W_MB ((bf16*)WSP(WS_WMIX_B))
#define P_W_MC ((bf16*)WSP(WS_WMIX_C))
#define P_H ((bf16*)WSP(WS_H))
#define P_HID ((bf16*)WSP(WS_R1))
#define P_HL ((bf16*)WSP(WS_R1))
#define P_AC ((bf16*)WSP(WS_R1 + 128 * MiB))
#define P_KRAW ((bf16*)WSP(WS_R1))
#define P_R2A ((bf16*)WSP(WS_R2A))
#define P_R2B ((bf16*)WSP(WS_R2B))
#define P_R2C ((bf16*)WSP(WS_R2C))
#define P_KB ((bf16*)WSP(WS_K))
#define P_VB ((bf16*)WSP(WS_V))
#define PT_BEGIN(k, cond) do { } while (0)
#define PT_END(k, cond) do { } while (0)
template <int layer>
__device__ __forceinline__ void run_layer(const Frame& F, volatile LAS unsigned* MISC, unsigned char* lds) {

#define MODL (P_MOD + layer * 6 * DM)
#define XSRC (layer == 0 ? IN(0) : (const float*)XO())
        if (layer > 0) {
            cvt_matrix(F, IN(6) + (size_t)layer * DM * FF, DM, FF, P_W_IN); cvt_matrix(F, IN(7) + (size_t)layer * DM * FF, FF, DM, P_W_OUT);
            if (layer < NA) { cvt_matrix(F, IN(8) + (size_t)layer * DM * 2 * DM, DM, 2 * DM, P_W_MA); cvt_matrix(F, IN(16) + (size_t)layer * DM * DM, DM, DM, P_W_MB);
                cvt_gates(F, IN(11) + (size_t)layer * 8 * 65536, IN(13) + (size_t)layer * 8 * 65536, P_W_MC); }
            else { cvt_matrix(F, IN(24) + (size_t)(layer - NA) * DM * DM, DM, DM, P_W_MA); cvt_matrix(F, IN(26) + (size_t)(layer - NA) * DM * DM, DM, DM, P_W_M8);
                if (layer == NA) cvt_matrix(F, IN(20), DM, 2 * DM, P_W_MB); }
            __syncthreads();
        }
#define XPREV (layer <= 1 ? IN(0) : (const float*)XO())
        if (layer == NA) { norm_rows<true>(F, XPREV, P_R2B, P_R2A, XO(), IN(17), P_MOD + NLAYER * 6 * DM, P_MOD + NLAYER * 6 * DM + DM, P_R2C, IN(22), IN(23), P_LOGF);
            norm_rows<false>(F, XO(), (const bf16*)nullptr, (const bf16*)nullptr, nullptr, IN(2) + layer * DM, MODL, MODL + DM, P_H, nullptr, nullptr, nullptr); }
        else if (layer == 0) norm_rows<false>(F, IN(0), (const bf16*)nullptr, (const bf16*)nullptr, nullptr, IN(2) + layer * DM, MODL, MODL + DM, P_H, nullptr, nullptr, nullptr);
        else norm_rows<false>(F, XPREV, P_R2B, P_R2A, XO(), IN(2) + layer * DM, MODL, MODL + DM, P_H, nullptr, nullptr, nullptr);
        GRID_BAR();
        if (layer < NA) {
            { const Frame FL = relaunder(F); pg8::Gemm g{P_H, P_W_MA, DM, DM, DM, 0}; pg8::StaticOrder S; S.init(M, 2 * DM, FL.G, FL.bid);
              pg8::EpiBf16<1> E{P_R2A, DM, 8, (size_t)(WS_R2B - WS_R2A) / 2, 8};
              pg8::gemm_phase(F.lds, g, S, E, FL.tid); }
            GRID_BAR();
            conv_rows(F, P_R2A, IN(9) + (size_t)layer * 4 * DM, IN(10) + (size_t)layer * DM, P_R2C);
            GRID_BAR();
            { const Frame FL = relaunder(F); pg8::Gemm g{P_R2C, P_W_MC, DM, 256, 256, 2}; pg8::StaticOrder S; S.init(M, 16 * 256, FL.G, FL.bid);
              pg8::EpiGate E{P_R2C, IN(12) + (size_t)layer * DM, IN(14) + (size_t)layer * DM, P_C8 + layer * DM, P_HL, P_AC, P_PC, P_HC};
              pg8::gemm_phase(F.lds, g, S, E, FL.tid); }
            GRID_BAR();
            scan_carry(F, P_PC, P_HC, P_CY);
            GRID_BAR();
            scan_fix(F, P_HL, P_AC, P_CY, P_R2B, P_R2A);
            GRID_BAR();
        } else {
            if (layer == NA) { build_F(F, P_LOGF, P_FC, IN(21), IN(25), (int*)WSP(WS_DESC));
              const Frame FL = relaunder(F); pg8::Gemm g{P_R2C, P_W_MB, DM, DM, DM, 0}; pg8::StaticOrder S; S.init(M, 2 * DM, FL.G, FL.bid);
              pg8::EpiHeadNorm E{P_KB, DM, 8, (size_t)(WS_V - WS_K) / 2, 8, IN(21), (LAS float*)(F.lds + XCH_OFF)};
              pg8::gemm_phase(F.lds, g, S, E, FL.tid); }
            { const Frame FL = relaunder(F); pg8::Gemm g{P_H, P_W_MA, DM, DM, DM, 0}; pg8::StaticOrder S; S.init(M, DM, FL.G, FL.bid, 4);
              pg8::EpiHeadNorm E{P_R2B, DM, 0, 0, 8, IN(25) + (size_t)(layer - NA) * DH, (LAS float*)(F.lds + XCH_OFF)};
              pg8::gemm_phase(F.lds, g, S, E, FL.tid); }
            GRID_BAR();
            attn_phase(F, (char*)lds, WSP(0), (unsigned)WS_R2B, (unsigned)WS_K, (unsigned)WS_V, (unsigned)WS_F, (unsigned)WS_R2C, (unsigned*)WSP(WS_CTL) + CW_Q + 64 * (layer - NA));
            GRID_BAR();
        }
        { const bf16* Ain = layer < NA ? P_R2A : P_R2C; const bf16* Wt = layer < NA ? P_W_MB : P_W_M8;
          const Frame FL = relaunder(F); pg8::Gemm g{Ain, Wt, DM, DM, DM, 0}; pg8::StaticOrder S; S.init(M, DM, FL.G, FL.bid, 4);
          pg8::EpiDelta E{P_R2B, MODL + 2 * DM, 0};
          pg8::gemm_phase(F.lds, g, S, E, FL.tid); }
        GRID_BAR();
        norm_rows<false>(F, XSRC, P_R2B, (const bf16*)nullptr, nullptr, IN(3) + layer * DM, MODL + 3 * DM, MODL + 4 * DM, P_H, nullptr, nullptr, nullptr);
        GRID_BAR();
#pragma clang loop unroll(disable)
        for (int q = 0; q < MLP_SPLIT; ++q) {
            constexpr int MQ = M / MLP_SPLIT;
            { const Frame FL = relaunder(F); pg8::Gemm g{P_H + (size_t)q * MQ * DM, P_W_IN, DM, DM, DM, 0}; pg8::StaticOrder S; S.init(MQ, FF, FL.G, FL.bid);
              pg8::EpiBf16<2> E{P_HID, 256, 0, 0, 0, FF / 256};
              pg8::gemm_phase(F.lds, g, S, E, FL.tid); }
            GRID_BAR();
            { const Frame FL = relaunder(F); pg8::Gemm g{P_HID, P_W_OUT, 256, FF, FF, 0, 1}; pg8::StaticOrder S; S.init(MQ, DM, FL.G, FL.bid, 4);
              if (layer + 1 < NLAYER) { pg8::EpiDelta E{P_R2A + (size_t)q * MQ * DM, MODL + 5 * DM, q * MQ}; pg8::gemm_phase(F.lds, g, S, E, FL.tid); }
              else { pg8::EpiResid E{XSRC + (size_t)q * MQ * DM, XO() + (size_t)q * MQ * DM, MODL + 5 * DM, q * MQ, P_R2B + (size_t)q * MQ * DM}; pg8::gemm_phase(F.lds, g, S, E, FL.tid); } }
            if (q + 1 < MLP_SPLIT) GRID_BAR();
        }
        if (layer + 1 < NLAYER) GRID_BAR();
}
__global__ void __launch_bounds__(NWAVES * 64, 2) yoco_fwd(Args args) {
    extern __shared__ __attribute__((aligned(16))) unsigned char lds[];
    Frame F;
    F.lds = (LAS unsigned char*)lds;
    volatile LAS unsigned* MISC = (volatile LAS unsigned*)(F.lds + MISC_OFF);
    F.tid = threadIdx.x; F.lane = F.tid & 63; F.wave = __builtin_amdgcn_readfirstlane(F.tid >> 6); F.bid = blockIdx.x;
    F.G = gridDim.x; { const int bx = blockIdx.x; F.vcu = (F.G % 8 == 0) ? (bx % 8) * (F.G / 8) + bx / 8 : bx; }
    F.gw = F.vcu * NWAVES + F.wave; F.NGW = F.G * NWAVES;
    for (int u = F.tid; u < (LDS_BYTES - LDSCTL_OFF) / 4; u += NWAVES * 64) ((LAS unsigned*)(F.lds + LDSCTL_OFF))[u] = 0u;
    __syncthreads();
    if (F.tid == 0) { LAS unsigned long long* t = (LAS unsigned long long*)(F.lds + PTAB_OFF);
#pragma unroll
        for (int i = 0; i < 27; ++i) t[i] = (unsigned long long)args.in[i];
        t[27] = (unsigned long long)args.out; t[28] = (unsigned long long)args.ws; }
    __syncthreads();
    (void)xcd_barrier_post((unsigned*)(WSP(WS_CTL)) + CW_BAR, MISC + 8);

    mod_gemv(F, IN(1), IN(4), IN(18), P_MODP);
    cvt_matrix(F, IN(6), DM, FF, P_W_IN); cvt_matrix(F, IN(7), FF, DM, P_W_OUT);
    cvt_matrix(F, IN(8), DM, 2 * DM, P_W_MA); cvt_matrix(F, IN(16), DM, DM, P_W_MB); cvt_gates(F, IN(11), IN(13), P_W_MC);
    GRID_BAR();
    { const float* b_mod = IN(5); const float* kv_b_mod = IN(19); const float* lam = IN(15); const float* MODP = P_MODP; float* MOD = P_MOD; float* C8 = P_C8;
      const Frame FL = relaunder(F);
      for (int i = FL.bid * (NWAVES * 64) + FL.tid; i < 2 * NCOLS_MOD; i += FL.G * NWAVES * 64) {
        const int b = i / NCOLS_MOD, col = i - b * NCOLS_MOD; float s = col < NLAYER * 6 * DM ? GP(const float, b_mod)[col] : GP(const float, kv_b_mod)[col - NLAYER * 6 * DM];
#pragma unroll
        for (int p = 0; p < KSPLIT; ++p) s += GP(const float, MODP)[(size_t)(p * 2 + b) * NCOLS_MOD + col];
        GP(float, MOD)[i] = s;
        if (i < NA * DM) GP(float, C8)[i] = -8.0f * log1pf(__expf(-GP(const float, lam)[i]));
      } }
    GRID_BAR();

    run_layer<0>(F, MISC, lds); run_layer<1>(F, MISC, lds); run_layer<2>(F, MISC, lds); run_layer<3>(F, MISC, lds);
}

extern "C" void kernel_launch(void* const* d_in, const int* in_sizes, int n_in, void* d_out, int out_size, void* d_ws, size_t ws_size, hipStream_t stream) {
    static int grid = 0;
    if (grid == 0) {
        if (n_in != 27 || in_sizes[0] != M * DM || out_size != M * DM || ws_size < WS_END) { fprintf(stderr, "kernel_launch: unexpected shapes (n_in %d, in0 %d, out %d, ws %zu); nothing launched\n", n_in, n_in > 0 ? in_sizes[0] : -1, out_size, ws_size); grid = -1; return; }
        int dev = 0, cus = 0, per_cu = 0;
        if (hipGetDevice(&dev) != hipSuccess || hipDeviceGetAttribute(&cus, hipDeviceAttributeMultiprocessorCount, dev) != hipSuccess) { grid = -1; return; }
        if (hipFuncSetAttribute((const void*)yoco_fwd, hipFuncAttributeMaxDynamicSharedMemorySize, LDS_BYTES) != hipSuccess) { fprintf(stderr, "kernel_launch: hipFuncSetAttribute failed\n"); grid = -1; return; }
        if (hipOccupancyMaxActiveBlocksPerMultiprocessor(&per_cu, (const void*)yoco_fwd, NWAVES * 64, LDS_BYTES) != hipSuccess || per_cu < 1) { fprintf(stderr, "kernel_launch: occupancy query says %d\n", per_cu); }
        (void)hipGetLastError();
        grid = cus;
    }
    if (grid < 0) return;
    if (hipMemsetAsync((char*)d_ws + WS_CTL, 0, CTL_ZERO_BYTES, stream) != hipSuccess) return;
    Args a{};
    for (int i = 0; i < 27; ++i) a.in[i] = (const float*)d_in[i];
    a.out = (float*)d_out; a.ws = (unsigned char*)d_ws;
    hipLaunchKernelGGL(yoco_fwd, dim3(grid), dim3(NWAVES * 64), LDS_BYTES, stream, a);
}
```
